# Optimizing an MI355X kernel written in HIP

```python
import jax, jax.numpy as jnp
from jax import lax
import numpy as np

D_MODEL = 1024
BATCH = 8
SEQ = 4096
DEPTH = 1

GRID_W = 64
CTX_LEN = 256
D_MIX = D_MODEL
D_A = D_MIX // 2
D_B = D_MIX - D_A
CHUNK = 128
SGU_GROUPS = 4
SGU_CH = D_A // SGU_GROUPS
NA_HEAD_DIM = 64
NA_HEADS = D_B // NA_HEAD_DIM
WIN_R = 8
WIN_C = 16
D_IN = 3 * D_A + 4 * D_B
BRANCH_WIDTHS = (D_A, D_A, D_A, D_B, D_B, D_B, D_B)
SPLIT_POINTS = tuple(int(s) for s in np.cumsum(BRANCH_WIDTHS)[:-1])
KV_START = 3 * D_A + D_B
KV_END = 3 * D_A + 3 * D_B
EPS = 1e-6
NEG_INF = -1e30

kernel_name = "hybrid_sgu_natten_prefix_block"


def rms_norm(x, g):
    xf = x.astype(jnp.float32)
    y = xf * lax.rsqrt(jnp.mean(xf * xf, axis=-1, keepdims=True) + EPS)
    return (y * g.astype(jnp.float32)).astype(x.dtype)


def ada_params(cond, w_ada, b_ada):
    mod = jax.nn.silu(cond) @ w_ada + b_ada
    shift, scale, gate = jnp.split(mod, 3, axis=-1)
    return shift[..., None, :], scale[..., None, :], gate[..., None, :]


def chunk_sgu(u, v, g, sgu_g, w_s, b_s):
    B, L, _ = u.shape
    u = jax.nn.gelu(u, approximate=False)
    v = jax.nn.gelu(v, approximate=False).reshape(B, L // CHUNK, CHUNK, SGU_GROUPS, SGU_CH)
    v = rms_norm(v, sgu_g.reshape(SGU_GROUPS, SGU_CH))
    mixed = jnp.einsum('gpq,bnqgc->bnpgc', w_s, v) + b_s.T[:, :, None]
    return u * mixed.reshape(B, L, D_A) * jax.nn.silu(g)


def neighborhood_attention(q, k, v, k_ctx, v_ctx, rpb):
    B, L, H, Dh = q.shape
    rows = L // GRID_W
    wr = min(WIN_R, rows)
    scale = Dh ** -0.5
    qg = q.reshape(B, rows, GRID_W, H, Dh)
    kg = k.reshape(B, rows, GRID_W, H, Dh)
    vg = v.reshape(B, rows, GRID_W, H, Dh)
    r = jnp.arange(rows)
    r0 = jnp.clip(r - WIN_R // 2, 0, rows - wr)
    key_rows = r0[:, None] + jnp.arange(wr)[None, :]
    kw = jnp.take(kg, key_rows, axis=1)
    vw = jnp.take(vg, key_rows, axis=1)
    dr = key_rows - r[:, None] + (WIN_R - 1)
    cols = jnp.arange(GRID_W)
    c0 = jnp.clip(cols - WIN_C // 2, 0, GRID_W - WIN_C)
    in_win = (cols[None, :] >= c0[:, None]) & (cols[None, :] < c0[:, None] + WIN_C)
    dc = jnp.clip(cols[None, :] - cols[:, None] + (WIN_C - 1), 0, 2 * WIN_C - 2)
    bias = rpb.astype(jnp.float32)[:, dr[:, None, :, None], dc[None, :, None, :]]
    bias = bias.transpose(1, 0, 2, 3, 4)
    s_lat = jnp.einsum('brqhd,brjkhd->brhqjk', qg, kw).astype(jnp.float32) * scale + bias[None]
    s_lat = jnp.where(in_win[:, None, :], s_lat, NEG_INF)
    s_ctx = jnp.einsum('brqhd,bchd->brhqc', qg, k_ctx).astype(jnp.float32) * scale
    m = jnp.maximum(jnp.max(s_lat, axis=(-2, -1)), jnp.max(s_ctx, axis=-1))
    p_lat = jnp.exp(s_lat - m[..., None, None])
    p_ctx = jnp.exp(s_ctx - m[..., None])
    denom = jnp.sum(p_lat, axis=(-2, -1)) + jnp.sum(p_ctx, axis=-1)
    out = (jnp.einsum('brhqjk,brjkhd->brqhd', p_lat.astype(v.dtype), vw)
           + jnp.einsum('brhqc,bchd->brqhd', p_ctx.astype(v.dtype), v_ctx))
    out = out / denom.transpose(0, 1, 3, 2)[..., None].astype(out.dtype)
    return out.reshape(B, L, H, Dh)


def context_attention(q, k, v):
    s = jnp.einsum('bqhd,bkhd->bhqk', q, k).astype(jnp.float32) * (q.shape[-1] ** -0.5)
    p = jax.nn.softmax(s, axis=-1).astype(v.dtype)
    return jnp.einsum('bhqk,bkhd->bqhd', p, v)


def setup_inputs(seed: int = 0) -> dict:
    key = jax.random.key(seed)
    ks = jax.random.split(key, 16)
    f32 = jnp.float32
    nrm = lambda k, shape: jax.random.normal(k, shape, dtype=f32)
    return {
        "x": nrm(ks[0], (BATCH, SEQ, D_MODEL)),
        "c": nrm(ks[1], (BATCH, D_MODEL)),
        "ctx": nrm(ks[2], (BATCH, CTX_LEN, D_MODEL)),
        "c_ctx": nrm(ks[3], (D_MODEL,)),
        "w_ada": nrm(ks[4], (DEPTH, D_MODEL, 3 * D_MODEL)) * (0.5 * D_MODEL ** -0.5),
        "b_ada": nrm(ks[5], (DEPTH, 3 * D_MODEL)) * 0.02,
        "norm_g": 1.0 + 0.02 * nrm(ks[6], (DEPTH, D_MODEL)),
        "w_in": nrm(ks[7], (DEPTH, D_MODEL, D_IN)) * D_MODEL ** -0.5,
        "sgu_norm_g": 1.0 + 0.02 * nrm(ks[8], (DEPTH, D_A)),
        "w_spatial": nrm(ks[9], (DEPTH, SGU_GROUPS, CHUNK, CHUNK)) * CHUNK ** -0.5,
        "b_spatial": nrm(ks[10], (DEPTH, SGU_GROUPS, CHUNK)) * 0.02,
        "q_norm_g": 1.0 + 0.02 * nrm(ks[11], (DEPTH, NA_HEAD_DIM)),
        "k_norm_g": 1.0 + 0.02 * nrm(ks[12], (DEPTH, NA_HEAD_DIM)),
        "rpb": nrm(ks[13], (DEPTH, NA_HEADS, 2 * WIN_R - 1, 2 * WIN_C - 1)) * 0.02,
        "w_out": nrm(ks[14], (DEPTH, D_MIX, D_MODEL)) * D_MIX ** -0.5,
    }


def reference(x, c, ctx, c_ctx, w_ada, b_ada, norm_g, w_in, sgu_norm_g, w_spatial,
              b_spatial, q_norm_g, k_norm_g, rpb, w_out):
    B, L, _ = x.shape
    Bc, C, _ = ctx.shape
    for layer in range(DEPTH):
        last = layer == DEPTH - 1
        shift, scale, gate = ada_params(c, w_ada[layer], b_ada[layer])
        cshift, cscale, cgate = ada_params(c_ctx, w_ada[layer], b_ada[layer])
        h = rms_norm(x, norm_g[layer]) * (1.0 + scale) + shift
        hc = rms_norm(ctx, norm_g[layer]) * (1.0 + cscale) + cshift

        z = h @ w_in[layer]
        a_u, a_v, a_g, b_q, b_k, b_v, b_g = jnp.split(z, SPLIT_POINTS, axis=-1)
        q = rms_norm(b_q.reshape(B, L, NA_HEADS, NA_HEAD_DIM), q_norm_g[layer])
        k = rms_norm(b_k.reshape(B, L, NA_HEADS, NA_HEAD_DIM), k_norm_g[layer])
        v = b_v.reshape(B, L, NA_HEADS, NA_HEAD_DIM)

        if last:
            ck, cv = jnp.split(hc @ w_in[layer][:, KV_START:KV_END], 2, axis=-1)
        else:
            zc = hc @ w_in[layer]
            cu, cvv, cga, cq, ck, cv, cgb = jnp.split(zc, SPLIT_POINTS, axis=-1)
        ck = rms_norm(ck.reshape(Bc, C, NA_HEADS, NA_HEAD_DIM), k_norm_g[layer])
        cv = cv.reshape(Bc, C, NA_HEADS, NA_HEAD_DIM)

        out_a = chunk_sgu(a_u, a_v, a_g, sgu_norm_g[layer], w_spatial[layer], b_spatial[layer])
        out_b = neighborhood_attention(q, k, v, ck, cv, rpb[layer]).reshape(B, L, D_B) * jax.nn.silu(b_g)
        mix = jnp.concatenate([out_a, out_b], axis=-1) @ w_out[layer]
        new_x = x + gate * mix

        if not last:
            cq = rms_norm(cq.reshape(Bc, C, NA_HEADS, NA_HEAD_DIM), q_norm_g[layer])
            cout_a = chunk_sgu(cu, cvv, cga, sgu_norm_g[layer], w_spatial[layer], b_spatial[layer])
            cout_b = context_attention(cq, ck, cv).reshape(Bc, C, D_B) * jax.nn.silu(cgb)
            cmix = jnp.concatenate([cout_a, cout_b], axis=-1) @ w_out[layer]
            ctx = ctx + cgate * cmix
        x = new_x
    return x
```

```cpp
#include <hip/hip_runtime.h>
#include <hip/hip_cooperative_groups.h>
#include <cstdio>
namespace cg = cooperative_groups;

#ifndef ONE_LAUNCH
#define ONE_LAUNCH 0
#endif

#define LAS __attribute__((address_space(3)))
typedef unsigned short bf16_t;
typedef short bf16x8 __attribute__((ext_vector_type(8)));
typedef short s16x4 __attribute__((ext_vector_type(4)));
typedef float f32x4 __attribute__((ext_vector_type(4)));
typedef float f32x2 __attribute__((ext_vector_type(2)));
typedef unsigned u32x4 __attribute__((ext_vector_type(4)));
typedef unsigned u32x2 __attribute__((ext_vector_type(2)));

constexpr int LTOT = 4352;
constexpr int MROWS = 8 * LTOT;
constexpr float LOG2E = 1.4426950408889634f;
constexpr float EPS = 1e-6f;
constexpr int LDS_BYTES = 131072;

struct Params {
    const float *x, *c, *ctx, *c_ctx, *w_ada, *b_ada, *norm_g, *w_in, *sgu_g, *w_sp, *b_sp, *qg, *kg, *rpb, *w_out;
    float* out;
    float* modp;
    float* gatef;
    bf16_t* H;
    bf16_t* WinT;
    bf16_t* WoutT;
    bf16_t* Wsp;
    bf16_t *U, *Vg, *G, *Q, *Kn, *BG;
    bf16_t* Vt;
    bf16_t* MIX;
};

__device__ __forceinline__ unsigned cvt_pk_bf16(float lo, float hi) { unsigned r; asm volatile("v_cvt_pk_bf16_f32 %0, %1, %2" : "=v"(r) : "v"(lo), "v"(hi)); return r; }
__device__ __forceinline__ float bf_lo(unsigned w) { return __uint_as_float(w << 16); }
__device__ __forceinline__ float bf_hi(unsigned w) { return __uint_as_float(w & 0xffff0000u); }
__device__ __forceinline__ float silu_f(float v) { return v * __builtin_amdgcn_rcpf(1.0f + __expf(-v)); }

namespace pg8 {
constexpr int BM = 256, BK = 64, HALF = 128, HTB = HALF * BK * 2, STAGE_BYTES = 8 * HTB, NXCD = 8, WGM = 8;
__host__ __device__ __forceinline__ int lds_byte(int r, int c) { const int st = (r >> 4) * 2 + (c >> 5), rr = r & 15, cc = c & 31, ob = rr * 64 + cc * 2; return st * 1024 + (ob ^ (((ob >> 9) & 1) << 5)); }
__host__ __device__ __forceinline__ void stage_rc(int b, int& R, int& C) { const int st = b / 1024, sb = b % 1024, swz = sb ^ (((sb >> 9) & 1) << 5); R = (st >> 1) * 16 + swz / 64; C = (st & 1) * 32 + (swz % 64) / 2; }
__host__ __device__ __forceinline__ int perm32(int rho) { const int n = rho >> 4, i = rho & 15; return 8 * (i >> 2) + 4 * n + (i & 3); }

struct Unit { int pm, pn; };
struct Gemm { const bf16_t* A; const bf16_t* Bt; int M, N, K; };

struct StaticOrder {
    int nM, nN, nwg, G, c;
    __host__ __device__ void init(int M, int N, int G_, int c_) { nM = M / BM; nN = N / BM; nwg = nM * nN; G = G_; c = c_; }
    __host__ __device__ bool next(int i, Unit& u) const {
        const long L = (long)i * G + c; if (L >= nwg) return false;
        int wgid = (int)L; { const int q = nwg / NXCD, r = nwg % NXCD, xcd = wgid % NXCD, off = wgid / NXCD; wgid = (xcd < r ? xcd * (q + 1) : r * (q + 1) + (xcd - r) * q) + off; }
        const int nig = WGM * nN, gid = wgid / nig, fm = gid * WGM, gsz = (nM - fm) < WGM ? (nM - fm) : WGM;
        u.pm = fm + ((wgid % nig) % gsz); u.pn = (wgid % nig) / gsz; return true;
    }
    __device__ __forceinline__ void a_ready(const Unit&) const {}
    __device__ __forceinline__ void done(const Unit&) const {}
};

__device__ __forceinline__ f32x2 gelu_pk(f32x2 v) {
    const f32x2 av = __builtin_elementwise_abs(v), d = av * 0.2316418882f + 1.0f;
    f32x2 t; t.x = __builtin_amdgcn_rcpf(d.x); t.y = __builtin_amdgcn_rcpf(d.y);
    f32x2 q = t * 0.5307027145f + (-0.7265760135f); q = q * t + 0.7107068705f; q = q * t + (-0.142248368f); q = q * t + 0.127414796f; q = q * t;
    const f32x2 s = (v * v) * (-0.72134752044f);
    f32x2 e; e.x = __builtin_amdgcn_exp2f(s.x); e.y = __builtin_amdgcn_exp2f(s.y);
    const f32x2 m = v * (q * e), r = v - m;
    f32x2 o; o.x = v.x < 0.f ? m.x : r.x; o.y = v.y < 0.f ? m.y : r.y; return o;
}

template <class Epi, class Sched>
__device__ __forceinline__ void gemm_phase(LAS unsigned char* lds, const Gemm g, const Sched& S, const Epi& E) {
    const int tid = threadIdx.x, wid = __builtin_amdgcn_readfirstlane(tid >> 6), lane = tid & 63, wr = wid >> 2, wc = wid & 3, fr = lane & 15, fq = lane >> 4;
    const int K = g.K, nt = K / BK;
    unsigned voffA[2], voffB[2];
#pragma unroll
    for (int i = 0; i < 2; ++i) { int R, C; stage_rc(tid * 16 + i * 8192, R, C); const int Rb = Epi::PERM ? ((R & ~31) + perm32(R & 31)) : R;
        voffA[i] = (unsigned)(R * K + C) * 2u; voffB[i] = (unsigned)(Rb * K + C) * 2u; }
    const size_t kstep = (size_t)(BK * 2);
    const size_t hstep = (size_t)HALF * K * 2;
    const size_t tstep = 2 * hstep;
    const unsigned ldsw = (unsigned)wid * 1024u;
    const int aoff = lds_byte(wr * 64 + fr, fq * 8), boff = lds_byte(wc * 32 + fr, fq * 8);
#define PG8_SA(b, h) (((b) * 2 + (h)) * HTB)
#define PG8_SB(b, h) ((4 + (b) * 2 + (h)) * HTB)
#define PG8_STAGE(bufoff, gbase, voff) do { _Pragma("unroll") for (int _i = 0; _i < 2; ++_i) \
        __builtin_amdgcn_global_load_lds((const unsigned*)((const char*)(gbase) + (voff)[_i]), (LAS unsigned*)(lds + (bufoff) + ldsw + _i * 8192), 16, 0, 0); } while (0)
#define PG8_LDA(dst, b, h) do { _Pragma("unroll") for (int m = 0; m < 4; ++m) _Pragma("unroll") for (int k = 0; k < 2; ++k) dst[m][k] = *(const LAS bf16x8*)(lds + PG8_SA(b, h) + aoff + m * 2048 + k * 1024); } while (0)
#define PG8_LDB(dst, b, h) do { _Pragma("unroll") for (int n = 0; n < 2; ++n) _Pragma("unroll") for (int k = 0; k < 2; ++k) dst[n][k] = *(const LAS bf16x8*)(lds + PG8_SB(b, h) + boff + n * 2048 + k * 1024); } while (0)
#define PG8_MMA(ai, bj, At, Bt) do { __builtin_amdgcn_s_setprio(1); _Pragma("unroll") for (int m = 0; m < 4; ++m) _Pragma("unroll") for (int n = 0; n < 2; ++n) _Pragma("unroll") for (int k = 0; k < 2; ++k) \
        acc[ai][bj][m][n] = __builtin_amdgcn_mfma_f32_16x16x32_bf16(Bt[n][k], At[m][k], acc[ai][bj][m][n], 0, 0, 0); __builtin_amdgcn_s_setprio(0); } while (0)
#define PG8_WAIT_V(n) asm volatile("s_waitcnt vmcnt(" #n ")" ::: "memory")
#define PG8_WAIT_L(n) asm volatile("s_waitcnt lgkmcnt(" #n ")" ::: "memory")
#define PG8_BAR __builtin_amdgcn_s_barrier()
#define PG8_SCHED __builtin_amdgcn_sched_barrier(0)
    Unit cur, nxt; int ui = 0;
    if (!S.next(0, cur)) return;
    f32x4 acc[2][2][4][2];
#pragma unroll
    for (int a = 0; a < 2; ++a)
#pragma unroll
        for (int b = 0; b < 2; ++b)
#pragma unroll
            for (int m = 0; m < 4; ++m)
#pragma unroll
                for (int n = 0; n < 2; ++n) acc[a][b][m][n] = (f32x4){0.f, 0.f, 0.f, 0.f};
    bf16x8 At[4][2], B0[2][2], B1[2][2];
    const char* cA = (const char*)g.A + (size_t)cur.pm * tstep; const char* cB = (const char*)g.Bt + (size_t)cur.pn * tstep;
    S.a_ready(cur);
    PG8_STAGE(PG8_SB(0, 0), cB, voffB); PG8_STAGE(PG8_SA(0, 0), cA, voffA); PG8_STAGE(PG8_SB(0, 1), cB + hstep, voffB); PG8_STAGE(PG8_SA(0, 1), cA + hstep, voffA);
    if (wr == 1) PG8_BAR;
    PG8_WAIT_V(4); PG8_BAR;
    PG8_STAGE(PG8_SB(1, 0), cB + kstep, voffB); PG8_STAGE(PG8_SA(1, 0), cA + kstep, voffA); PG8_STAGE(PG8_SB(1, 1), cB + hstep + kstep, voffB);
    PG8_WAIT_V(6); PG8_BAR;
    for (;;) {
        const bool has_next = S.next(ui + 1, nxt);
        const char* nA = has_next ? (const char*)g.A + (size_t)nxt.pm * tstep : cA; const char* nB = has_next ? (const char*)g.Bt + (size_t)nxt.pn * tstep : cB;
        for (int t = 0; t < nt; t += 2) {
            const bool last = (t == nt - 2);
            const char* a1 = cA + (size_t)(t + 1) * kstep;
            const char* a2 = last ? nA : cA + (size_t)(t + 2) * kstep; const char* b2 = last ? nB : cB + (size_t)(t + 2) * kstep;
            const char* a3 = a2 + kstep; const char* b3 = b2 + kstep;
            if (last && has_next) S.a_ready(nxt);
            PG8_LDB(B0, 0, 0); PG8_SCHED; PG8_LDA(At, 0, 0); PG8_STAGE(PG8_SA(1, 1), a1 + hstep, voffA);
            PG8_WAIT_L(8); PG8_BAR; PG8_WAIT_L(0); PG8_MMA(0, 0, At, B0); PG8_BAR; PG8_SCHED;
            PG8_LDB(B1, 0, 1); PG8_STAGE(PG8_SB(0, 0), b2, voffB);
            PG8_BAR; PG8_WAIT_L(0); PG8_MMA(0, 1, At, B1); PG8_BAR;
            PG8_LDA(At, 0, 1); PG8_STAGE(PG8_SA(0, 0), a2, voffA);
            PG8_BAR; PG8_WAIT_L(0); PG8_MMA(1, 0, At, B0); PG8_BAR; PG8_SCHED;
            PG8_STAGE(PG8_SB(0, 1), b2 + hstep, voffB);
            PG8_WAIT_V(6); PG8_BAR; PG8_MMA(1, 1, At, B1); PG8_BAR;
            PG8_LDB(B0, 1, 0); PG8_SCHED; PG8_LDA(At, 1, 0); PG8_STAGE(PG8_SA(0, 1), a2 + hstep, voffA);
            PG8_WAIT_L(8); PG8_BAR; PG8_WAIT_L(0); PG8_MMA(0, 0, At, B0); PG8_BAR; PG8_SCHED;
            PG8_LDB(B1, 1, 1); PG8_STAGE(PG8_SB(1, 0), b3, voffB);
            PG8_BAR; PG8_WAIT_L(0); PG8_MMA(0, 1, At, B1); PG8_BAR;
            PG8_LDA(At, 1, 1); PG8_STAGE(PG8_SA(1, 0), a3, voffA);
            PG8_BAR; PG8_WAIT_L(0); PG8_MMA(1, 0, At, B0); PG8_BAR; PG8_SCHED;
            PG8_STAGE(PG8_SB(1, 1), b3 + hstep, voffB);
            PG8_WAIT_V(6); PG8_BAR; PG8_MMA(1, 1, At, B1); PG8_BAR;
        }
        E(acc, cur, wr, wc, fr, fq); S.done(cur);
        if (!has_next) break;
#pragma unroll
        for (int a = 0; a < 2; ++a)
#pragma unroll
            for (int b = 0; b < 2; ++b)
#pragma unroll
                for (int m = 0; m < 4; ++m)
#pragma unroll
                    for (int n = 0; n < 2; ++n) acc[a][b][m][n] = (f32x4){0.f, 0.f, 0.f, 0.f};
        cur = nxt; cA = nA; cB = nB; ++ui;
    }
    PG8_WAIT_V(0);
    if (wr == 0) PG8_BAR;
    PG8_BAR;
#undef PG8_SA
#undef PG8_SB
#undef PG8_STAGE
#undef PG8_LDA
#undef PG8_LDB
#undef PG8_MMA
#undef PG8_WAIT_V
#undef PG8_WAIT_L
#undef PG8_BAR
#undef PG8_SCHED
}
}

struct Sched1 {
    int G, c;
    __device__ bool next(int i, pg8::Unit& u) const {
        const int L = i * G + c; if (L >= 1824) return false;
        if (L < 1792) {
            const int wgid = (L & 7) * 224 + (L >> 3);
            const int gid = wgid / 112, rem = wgid - gid * 112;
            const int pml = gid * 8 + (rem & 7);
            u.pm = pml + (pml >> 4); u.pn = rem >> 3;
        } else { const int j = L - 1792; u.pm = (j >> 2) * 17 + 16; u.pn = 8 + (j & 3); }
        return true;
    }
    __device__ __forceinline__ void a_ready(const pg8::Unit&) const {}
    __device__ __forceinline__ void done(const pg8::Unit&) const {}
};

struct Epi1 {
    static constexpr bool PERM = true;
    bf16_t *U, *Vg, *G, *Q, *Kn, *BG, *Vt; const float *qg, *kg;
    __device__ __forceinline__ void operator()(const f32x4 (&acc)[2][2][4][2], const pg8::Unit& u, int wr, int wc, int fr, int fq) const {
        const int type = u.pn >> 1, half = u.pn & 1;
        const size_t row0 = (size_t)u.pm * 256 + wr * 64 + fr;
        if (type == 5) {
            const int b = u.pm / 17, t0 = (u.pm - b * 17) * 256 + wr * 64 + fr;
#pragma unroll
            for (int bj = 0; bj < 2; ++bj)
#pragma unroll
                for (int n = 0; n < 2; ++n)
#pragma unroll
                    for (int e = 0; e < 4; ++e) {
                        const int cc = half * 256 + bj * 128 + wc * 32 + 8 * fq + 4 * n + e;
                        bf16_t* base = Vt + ((size_t)b * 512 + cc) * LTOT + t0;
#pragma unroll
                        for (int ai = 0; ai < 2; ++ai)
#pragma unroll
                            for (int m = 0; m < 4; ++m) base[ai * 128 + m * 16] = (bf16_t)(cvt_pk_bf16(acc[ai][bj][m][n][e], 0.f) & 0xffffu);
                    }
        } else if (type == 3 || type == 4) {
            const float* gw = (type == 3) ? qg : kg; const float mul = (type == 3) ? 0.125f * LOG2E : 1.0f;
            bf16_t* O = (type == 3) ? Q : Kn;
            f32x4 gv[2][2];
#pragma unroll
            for (int bj = 0; bj < 2; ++bj)
#pragma unroll
                for (int n = 0; n < 2; ++n) gv[bj][n] = *(const f32x4*)(gw + bj * 32 + 8 * fq + 4 * n) * mul;
            const int colbase = half * 256 + wc * 64 + 8 * fq;
#pragma unroll
            for (int ai = 0; ai < 2; ++ai)
#pragma unroll
                for (int m = 0; m < 4; ++m) {
                    float ss = 0.f;
#pragma unroll
                    for (int bj = 0; bj < 2; ++bj)
#pragma unroll
                        for (int n = 0; n < 2; ++n) { const f32x4 v = acc[ai][bj][m][n]; ss += (v[0] * v[0] + v[1] * v[1]) + (v[2] * v[2] + v[3] * v[3]); }
                    ss += __shfl_xor(ss, 16); ss += __shfl_xor(ss, 32);
                    const float rstd = __builtin_amdgcn_rsqf(ss * (1.0f / 64.0f) + EPS);
                    bf16_t* rowp = O + (row0 + ai * 128 + m * 16) * 512 + colbase;
#pragma unroll
                    for (int bj = 0; bj < 2; ++bj) {
                        const f32x4 v0 = acc[ai][bj][m][0] * rstd * gv[bj][0], v1 = acc[ai][bj][m][1] * rstd * gv[bj][1];
                        u32x4 w; w.x = cvt_pk_bf16(v0[0], v0[1]); w.y = cvt_pk_bf16(v0[2], v0[3]); w.z = cvt_pk_bf16(v1[0], v1[1]); w.w = cvt_pk_bf16(v1[2], v1[3]);
                        *(u32x4*)(rowp + bj * 32) = w;
                    }
                }
        } else {
            bf16_t* O = (type == 0) ? U : (type == 1) ? Vg : (type == 2) ? G : BG;
            const int col0 = half * 256 + wc * 32 + 8 * fq;
            const bool is_gelu = type <= 1;
#pragma unroll
            for (int ai = 0; ai < 2; ++ai)
#pragma unroll
                for (int m = 0; m < 4; ++m) {
                    bf16_t* rowp = O + (row0 + ai * 128 + m * 16) * 512 + col0;
#pragma unroll
                    for (int bj = 0; bj < 2; ++bj) {
                        f32x4 v0 = acc[ai][bj][m][0], v1 = acc[ai][bj][m][1];
                        if (is_gelu) {
                            const f32x2 a = pg8::gelu_pk((f32x2){v0[0], v0[1]}), b = pg8::gelu_pk((f32x2){v0[2], v0[3]}), c = pg8::gelu_pk((f32x2){v1[0], v1[1]}), d = pg8::gelu_pk((f32x2){v1[2], v1[3]});
                            v0 = (f32x4){a.x, a.y, b.x, b.y}; v1 = (f32x4){c.x, c.y, d.x, d.y};
                        } else {
#pragma unroll
                            for (int j = 0; j < 4; ++j) { v0[j] = silu_f(v0[j]); v1[j] = silu_f(v1[j]); }
                        }
                        u32x4 w; w.x = cvt_pk_bf16(v0[0], v0[1]); w.y = cvt_pk_bf16(v0[2], v0[3]); w.z = cvt_pk_bf16(v1[0], v1[1]); w.w = cvt_pk_bf16(v1[2], v1[3]);
                        *(u32x4*)(rowp + bj * 128) = w;
                    }
                }
        }
    }
};

struct EpiOut {
    static constexpr bool PERM = false;
    const float* x; const float* gatef; float* out;
    __device__ __forceinline__ void operator()(const f32x4 (&acc)[2][2][4][2], const pg8::Unit& u, int wr, int wc, int fr, int fq) const {
        const size_t row0 = (size_t)u.pm * 256 + wr * 64 + fr; const int col0 = u.pn * 256 + wc * 32 + 4 * fq; const int b = u.pm >> 4;
        f32x4 gv[2][2];
#pragma unroll
        for (int bj = 0; bj < 2; ++bj)
#pragma unroll
            for (int n = 0; n < 2; ++n) gv[bj][n] = *(const f32x4*)(gatef + b * 1024 + col0 + bj * 128 + n * 16);
#pragma unroll
        for (int ai = 0; ai < 2; ++ai)
#pragma unroll
            for (int m = 0; m < 4; ++m) {
                const size_t ro = (row0 + ai * 128 + m * 16) * 1024 + col0;
#pragma unroll
                for (int bj = 0; bj < 2; ++bj)
#pragma unroll
                    for (int n = 0; n < 2; ++n) {
                        const f32x4 xv = *(const f32x4*)(x + ro + bj * 128 + n * 16);
                        *(f32x4*)(out + ro + bj * 128 + n * 16) = xv + gv[bj][n] * acc[ai][bj][m][n];
                    }
            }
    }
};

__device__ __forceinline__ int win_actual_col(int n) {
    if (n < 1536 || n >= 2560) return n;
    const int g = n & 255;
    return (n & ~255) + ((g >> 5) & 3) * 64 + (g >> 7) * 32 + (g & 31);
}
__device__ __forceinline__ void transpose_item(const float* W, int N, bf16_t* WT, int K, int n0, int k0, bool perm, LAS float* tl, int tid) {
    __syncthreads();
    { const int kr = tid >> 3, ch = tid & 7; const int nn = n0 + ch * 8; const int src_c = perm ? win_actual_col(nn) : nn;
      const float* src = W + (size_t)(k0 + kr) * N + src_c;
      const f32x4 a = *(const f32x4*)src, b = *(const f32x4*)(src + 4);
      LAS float* d = tl + (ch * 8) * 65 + kr;
      d[0] = a[0]; d[65] = a[1]; d[130] = a[2]; d[195] = a[3]; d[260] = b[0]; d[325] = b[1]; d[390] = b[2]; d[455] = b[3]; }
    __syncthreads();
    { const int nr = tid >> 3, kc = tid & 7; const LAS float* s = tl + nr * 65 + kc * 8;
      u32x4 w; w.x = cvt_pk_bf16(s[0], s[1]); w.y = cvt_pk_bf16(s[2], s[3]); w.z = cvt_pk_bf16(s[4], s[5]); w.w = cvt_pk_bf16(s[6], s[7]);
      *(u32x4*)(WT + (size_t)(n0 + nr) * K + k0 + kc * 8) = w; }
}
__device__ __forceinline__ void phase0(const Params& p, LAS unsigned char* lds, int tid) {
    LAS float* fl = (LAS float*)lds;
    constexpr int I_ADA = 384, I_WIN = 896, I_WOUT = 256, I_TOT = I_ADA + I_WIN + I_WOUT;
    for (int it = blockIdx.x; it < I_TOT; it += gridDim.x) {
        if (it < I_ADA) {
            const int cgi = it >> 5, ks = it & 31;
            __syncthreads();
            if (tid < 288) { const int r = tid >> 5, kk = tid & 31, k = ks * 32 + kk; const float cv = (r < 8) ? p.c[r * 1024 + k] : p.c_ctx[k]; fl[tid] = cv / (1.0f + __expf(-cv)); }
            __syncthreads();
            const int col = cgi * 256 + (tid & 255), kh = tid >> 8;
            float a0 = 0.f, a1 = 0.f, a2 = 0.f, a3 = 0.f, a4 = 0.f, a5 = 0.f, a6 = 0.f, a7 = 0.f, a8 = 0.f;
#pragma unroll 4
            for (int kk = 0; kk < 16; ++kk) {
                const int kl = kh * 16 + kk; const float w = p.w_ada[(size_t)(ks * 32 + kl) * 3072 + col];
                a0 += fl[kl] * w; a1 += fl[32 + kl] * w; a2 += fl[64 + kl] * w; a3 += fl[96 + kl] * w; a4 += fl[128 + kl] * w;
                a5 += fl[160 + kl] * w; a6 += fl[192 + kl] * w; a7 += fl[224 + kl] * w; a8 += fl[256 + kl] * w;
            }
            LAS float* ex = fl + 288; const int tc = tid & 255;
            if (kh == 1) { ex[tc] = a0; ex[256 + tc] = a1; ex[512 + tc] = a2; ex[768 + tc] = a3; ex[1024 + tc] = a4; ex[1280 + tc] = a5; ex[1536 + tc] = a6; ex[1792 + tc] = a7; ex[2048 + tc] = a8; }
            __syncthreads();
            if (kh == 0) { float* o = p.modp + (size_t)(ks * 9) * 3072 + col;
                o[0] = a0 + ex[tc]; o[3072] = a1 + ex[256 + tc]; o[2 * 3072] = a2 + ex[512 + tc]; o[3 * 3072] = a3 + ex[768 + tc]; o[4 * 3072] = a4 + ex[1024 + tc];
                o[5 * 3072] = a5 + ex[1280 + tc]; o[6 * 3072] = a6 + ex[1536 + tc]; o[7 * 3072] = a7 + ex[1792 + tc]; o[8 * 3072] = a8 + ex[2048 + tc]; }
        } else if (it < I_ADA + I_WIN) {
            const int r = it - I_ADA; transpose_item(p.w_in, 3584, p.WinT, 1024, (r >> 4) * 64, (r & 15) * 64, true, fl, tid);
        } else {
            const int r = it - I_ADA - I_WIN; transpose_item(p.w_out, 1024, p.WoutT, 1024, (r >> 4) * 64, (r & 15) * 64, false, fl, tid);
        }
    }
    for (int i = blockIdx.x * 512 + tid; i < 32768; i += gridDim.x * 512) { const float a = p.w_sp[2 * i], b = p.w_sp[2 * i + 1]; ((unsigned*)p.Wsp)[i] = cvt_pk_bf16(a, b); }
}

__device__ __forceinline__ void phase1(const Params& p, LAS unsigned char* lds, int tid, int wid, int lane) {
    LAS float* gs = (LAS float*)lds; LAS float* sh = gs + 1024; LAS float* cgs = gs + 2048; LAS float* csh = gs + 3072;
    for (int rg = blockIdx.x; rg < 256; rg += gridDim.x) {
        const int b = rg >> 5, sub = rg & 31;
        __syncthreads();
        for (int k = tid; k < 1024; k += 512) {
            float s_sh = p.b_ada[k], s_sc = p.b_ada[1024 + k], s_g = p.b_ada[2048 + k], c_sh = s_sh, c_sc = s_sc;
            for (int ks = 0; ks < 32; ++ks) {
                const float* mb = p.modp + (size_t)(ks * 9 + b) * 3072 + k; const float* mc = p.modp + (size_t)(ks * 9 + 8) * 3072 + k;
                s_sh += mb[0]; s_sc += mb[1024]; s_g += mb[2048]; c_sh += mc[0]; c_sc += mc[1024];
            }
            const float g = p.norm_g[k];
            gs[k] = g * (1.0f + s_sc); sh[k] = s_sh; cgs[k] = g * (1.0f + c_sc); csh[k] = c_sh;
            if (sub == 0) p.gatef[b * 1024 + k] = s_g;
        }
        __syncthreads();
        for (int i = 0; i < 17; ++i) {
            const int lr = i * 8 + wid; const bool lat = lr < 128;
            const float* src = lat ? p.x + ((size_t)b * 4096 + sub * 128 + lr) * 1024 : p.ctx + ((size_t)b * 256 + sub * 8 + (lr - 128)) * 1024;
            const size_t drow = lat ? (size_t)b * LTOT + sub * 128 + lr : (size_t)b * LTOT + 4096 + sub * 8 + (lr - 128);
            const LAS float* sc_ = lat ? gs : cgs; const LAS float* sh_ = lat ? sh : csh;
            f32x4 v[4]; float ss = 0.f;
#pragma unroll
            for (int j = 0; j < 4; ++j) { v[j] = *(const f32x4*)(src + j * 256 + lane * 4); ss += (v[j][0] * v[j][0] + v[j][1] * v[j][1]) + (v[j][2] * v[j][2] + v[j][3] * v[j][3]); }
#pragma unroll
            for (int o = 1; o < 64; o <<= 1) ss += __shfl_xor(ss, o);
            const float rstd = __builtin_amdgcn_rsqf(ss * (1.0f / 1024.0f) + EPS);
            bf16_t* drp = p.H + drow * 1024;
#pragma unroll
            for (int j = 0; j < 4; ++j) {
                const int k = j * 256 + lane * 4;
                const f32x4 a = *(const LAS f32x4*)(sc_ + k), s = *(const LAS f32x4*)(sh_ + k);
                const f32x4 hv = v[j] * rstd * a + s;
                u32x2 w; w.x = cvt_pk_bf16(hv[0], hv[1]); w.y = cvt_pk_bf16(hv[2], hv[3]);
                *(u32x2*)(drp + k) = w;
            }
        }
    }
}

__device__ __forceinline__ void sgu_phase(const Params& p, LAS unsigned char* lds, int tid, int wid, int lane) {
    constexpr int RS = 272;
    LAS unsigned char* wsL = lds + 32768; LAS unsigned char* vL = wsL + 128 * RS;
    const int fr = lane & 15, fq = lane >> 4;
    for (int unit = blockIdx.x; unit < 256; unit += gridDim.x) {
        const int b = unit >> 5, n = unit & 31;
        const size_t rowbase = (size_t)b * LTOT + n * 128, mixrow = (size_t)b * 4096 + n * 128;
        for (int g = 0; g < 4; ++g) {
            __syncthreads();
#pragma unroll
            for (int i = 0; i < 4; ++i) { const int idx = tid + 512 * i, row = idx >> 4, ch = idx & 15;
                *(LAS u32x4*)(wsL + row * RS + ch * 16) = *(const u32x4*)(p.Wsp + (size_t)(g * 128 + row) * 128 + ch * 8); }
            { const int q = tid >> 2, qt = tid & 3;
              const bf16_t* vp = p.Vg + (rowbase + q) * 512 + g * 128 + 32 * qt;
              u32x4 raw[4]; float ss = 0.f;
#pragma unroll
              for (int i = 0; i < 4; ++i) { raw[i] = *(const u32x4*)(vp + 8 * i);
#pragma unroll
                  for (int j = 0; j < 4; ++j) { const float a = bf_lo(raw[i][j]), bb = bf_hi(raw[i][j]); ss += a * a + bb * bb; } }
              ss += __shfl_xor(ss, 1); ss += __shfl_xor(ss, 2);
              const float rstd = __builtin_amdgcn_rsqf(ss * (1.0f / 128.0f) + EPS);
              const float* gp = p.sgu_g + g * 128 + 32 * qt;
#pragma unroll
              for (int i = 0; i < 4; ++i) { u32x4 w;
#pragma unroll
                  for (int j = 0; j < 4; ++j) w[j] = cvt_pk_bf16(bf_lo(raw[i][j]) * rstd * gp[8 * i + 2 * j], bf_hi(raw[i][j]) * rstd * gp[8 * i + 2 * j + 1]);
                  *(LAS u32x4*)(vL + q * RS + 64 * qt + 16 * i) = w; } }
            __syncthreads();
            bf16x8 wf[4];
#pragma unroll
            for (int ks = 0; ks < 4; ++ks) wf[ks] = *(const LAS bf16x8*)(wsL + (16 * wid + fr) * RS + ks * 64 + fq * 16);
            const float bias = p.b_sp[g * 128 + 16 * wid + fr];
            const int traddr = (8 * fq + ((lane & 15) >> 2)) * RS + 8 * (lane & 3);
            const size_t grow = rowbase + 16 * wid + fr;
#pragma unroll
            for (int cb = 0; cb < 8; ++cb) {
                f32x4 acc = {0.f, 0.f, 0.f, 0.f};
#pragma unroll
                for (int ks = 0; ks < 4; ++ks) {
                    const s16x4 a0 = __builtin_amdgcn_ds_read_tr16_b64_v4i16((LAS s16x4*)(vL + traddr + (32 * ks) * RS + 32 * cb));
                    const s16x4 a1 = __builtin_amdgcn_ds_read_tr16_b64_v4i16((LAS s16x4*)(vL + traddr + (32 * ks + 4) * RS + 32 * cb));
                    const bf16x8 a = {a0[0], a0[1], a0[2], a0[3], a1[0], a1[1], a1[2], a1[3]};
                    acc = __builtin_amdgcn_mfma_f32_16x16x32_bf16(a, wf[ks], acc, 0, 0, 0);
                }
                const int colc = g * 128 + 16 * cb + 4 * fq;
                const u32x2 uu = *(const u32x2*)(p.U + grow * 512 + colc), gg = *(const u32x2*)(p.G + grow * 512 + colc);
                const float o0 = bf_lo(uu.x) * (acc[0] + bias) * bf_lo(gg.x), o1 = bf_hi(uu.x) * (acc[1] + bias) * bf_hi(gg.x);
                const float o2 = bf_lo(uu.y) * (acc[2] + bias) * bf_lo(gg.y), o3 = bf_hi(uu.y) * (acc[3] + bias) * bf_hi(gg.y);
                u32x2 w; w.x = cvt_pk_bf16(o0, o1); w.y = cvt_pk_bf16(o2, o3);
                *(u32x2*)(p.MIX + (mixrow + 16 * wid + fr) * 1024 + colc) = w;
            }
        }
    }
}

__device__ __forceinline__ void attn_phase(const Params& p, LAS unsigned char* lds, int tid, int wid, int lane) {
    LAS float* tbl = (LAS float*)lds;
    for (int i = tid; i < 8 * 15 * 64; i += 512) {
        const int h = i / 960, rem = i - h * 960, dr = rem >> 6, xx = (rem & 63) - 16;
        tbl[i] = (xx >= 0 && xx <= 30) ? p.rpb[h * 465 + dr * 31 + xx] * LOG2E : 0.f;
    }
    __syncthreads();
    const int fr = lane & 15, fq = lane >> 4;
    const int gw = blockIdx.x * 8 + wid, nW = gridDim.x * 8;
    for (int wu = gw; wu < 16384; wu += nW) {
        const int j = wu & 3, h = (wu >> 2) & 7, r = (wu >> 5) & 63, b = wu >> 11;
        const int r0 = min(max(r - 4, 0), 56);
        const int cs = (j == 0) ? 0 : (j == 1) ? 8 : (j == 2) ? 24 : 32;
        const int c = 16 * j + fr, c0 = min(max(c - 8, 0), 48);
        const size_t rowbase = (size_t)b * LTOT;
        const bf16_t* qp = p.Q + (rowbase + r * 64 + c) * 512 + h * 64 + fq * 8;
        const bf16x8 q0 = *(const bf16x8*)qp, q1 = *(const bf16x8*)(qp + 32);
        f32x4 o[4];
#pragma unroll
        for (int d = 0; d < 4; ++d) o[d] = (f32x4){0.f, 0.f, 0.f, 0.f};
        float m = -1e30f, l = 0.f;
        const bf16_t* kbase = p.Kn + (rowbase + 8 * (fr >> 2) + (fr & 3)) * 512 + h * 64 + fq * 8;
        const bf16_t* vbase = p.Vt + ((size_t)(b * 8 + h) * 64 + fr) * LTOT + fq * 8;
        const int lo = c0 - (cs + 8 * fq);
        const int dcb = cs + 8 * fq - c + 15 + 16;
#pragma unroll 2
        for (int blk = 0; blk < 16; ++blk) {
            const bool win = blk < 8;
            const int tokbase = win ? (r0 + blk) * 64 + cs : 4096 + (blk - 8) * 32;
            const bf16_t* kp = kbase + (size_t)tokbase * 512;
            const bf16x8 k00 = *(const bf16x8*)kp, k01 = *(const bf16x8*)(kp + 32), k10 = *(const bf16x8*)(kp + 4 * 512), k11 = *(const bf16x8*)(kp + 4 * 512 + 32);
            const bf16_t* vp = vbase + tokbase;
            bf16x8 vf[4];
#pragma unroll
            for (int d = 0; d < 4; ++d) vf[d] = *(const bf16x8*)(vp + (size_t)d * 16 * LTOT);
            f32x4 s0 = {0.f, 0.f, 0.f, 0.f}, s1 = {0.f, 0.f, 0.f, 0.f};
            s0 = __builtin_amdgcn_mfma_f32_16x16x32_bf16(k00, q0, s0, 0, 0, 0); s0 = __builtin_amdgcn_mfma_f32_16x16x32_bf16(k01, q1, s0, 0, 0, 0);
            s1 = __builtin_amdgcn_mfma_f32_16x16x32_bf16(k10, q0, s1, 0, 0, 0); s1 = __builtin_amdgcn_mfma_f32_16x16x32_bf16(k11, q1, s1, 0, 0, 0);
            float s[8] = {s0[0], s0[1], s0[2], s0[3], s1[0], s1[1], s1[2], s1[3]};
            if (win) {
                const LAS float* tb = tbl + (h * 15 + (r0 + blk - r + 7)) * 64 + dcb;
#pragma unroll
                for (int e = 0; e < 8; ++e) s[e] = ((unsigned)(e - lo) < 16u) ? s[e] + tb[e] : -1e30f;
            }
            float mx = fmaxf(fmaxf(fmaxf(s[0], s[1]), fmaxf(s[2], s[3])), fmaxf(fmaxf(s[4], s[5]), fmaxf(s[6], s[7])));
            mx = fmaxf(mx, __shfl_xor(mx, 16)); mx = fmaxf(mx, __shfl_xor(mx, 32));
            const float mn = fmaxf(m, mx), alpha = __builtin_amdgcn_exp2f(m - mn); m = mn;
            float ps = 0.f;
#pragma unroll
            for (int e = 0; e < 8; ++e) { s[e] = __builtin_amdgcn_exp2f(s[e] - mn); ps += s[e]; }
            l = l * alpha + ps;
#pragma unroll
            for (int d = 0; d < 4; ++d) o[d] = o[d] * alpha;
            union { u32x4 u; bf16x8 v; } pf;
            pf.u.x = cvt_pk_bf16(s[0], s[1]); pf.u.y = cvt_pk_bf16(s[2], s[3]); pf.u.z = cvt_pk_bf16(s[4], s[5]); pf.u.w = cvt_pk_bf16(s[6], s[7]);
#pragma unroll
            for (int d = 0; d < 4; ++d) o[d] = __builtin_amdgcn_mfma_f32_16x16x32_bf16(vf[d], pf.v, o[d], 0, 0, 0);
        }
        l += __shfl_xor(l, 16); l += __shfl_xor(l, 32);
        const float inv = 1.0f / l;
        const bf16_t* bgp = p.BG + (rowbase + r * 64 + c) * 512 + h * 64 + 4 * fq;
        bf16_t* op = p.MIX + ((size_t)b * 4096 + r * 64 + c) * 1024 + 512 + h * 64 + 4 * fq;
#pragma unroll
        for (int d = 0; d < 4; ++d) {
            const u32x2 gg = *(const u32x2*)(bgp + 16 * d);
            u32x2 w; w.x = cvt_pk_bf16(o[d][0] * inv * bf_lo(gg.x), o[d][1] * inv * bf_hi(gg.x)); w.y = cvt_pk_bf16(o[d][2] * inv * bf_lo(gg.y), o[d][3] * inv * bf_hi(gg.y));
            *(u32x2*)(op + 16 * d) = w;
        }
    }
}

__device__ __forceinline__ void run_phase(const Params& p, int ph, LAS unsigned char* lds) {
    const int tid = threadIdx.x, wid = __builtin_amdgcn_readfirstlane(tid >> 6), lane = tid & 63;
    if (ph == 0) phase0(p, lds, tid);
    else if (ph == 1) phase1(p, lds, tid, wid, lane);
    else if (ph == 2) {
        pg8::Gemm g{p.H, p.WinT, MROWS, 3584, 1024};
        Sched1 S{(int)gridDim.x, (int)blockIdx.x};
        Epi1 E{p.U, p.Vg, p.G, p.Q, p.Kn, p.BG, p.Vt, p.qg, p.kg};
        pg8::gemm_phase<Epi1, Sched1>(lds, g, S, E);
    } else if (ph == 3) {
        sgu_phase(p, lds, tid, wid, lane);
        attn_phase(p, lds, tid, wid, lane);
    } else {
        pg8::Gemm g{p.MIX, p.WoutT, 32768, 1024, 1024};
        pg8::StaticOrder S; S.init(32768, 1024, (int)gridDim.x, (int)blockIdx.x);
        EpiOut E{p.x, p.gatef, p.out};
        pg8::gemm_phase<EpiOut, pg8::StaticOrder>(lds, g, S, E);
    }
}

#if ONE_LAUNCH
__global__ __launch_bounds__(512, 2) void k_mega(Params p) {
    extern __shared__ __attribute__((aligned(16))) unsigned char shm[];
    LAS unsigned char* lds = (LAS unsigned char*)shm;
    cg::grid_group grid = cg::this_grid();
    run_phase(p, 0, lds); grid.sync();
    run_phase(p, 1, lds); grid.sync();
    run_phase(p, 2, lds); grid.sync();
    run_phase(p, 3, lds); grid.sync();
    run_phase(p, 4, lds);
}
#else
template <int PH> __global__ __launch_bounds__(512, 2) void k_phase(Params p) {
    extern __shared__ __attribute__((aligned(16))) unsigned char shm[];
    run_phase(p, PH, (LAS unsigned char*)shm);
}
#endif

extern "C" void kernel_launch(void* const* d_in, const int* in_sizes, int n_in, void* d_out, int out_size, void* d_ws, size_t ws_size, hipStream_t stream) {
    Params p{};
    p.x = (const float*)d_in[0]; p.c = (const float*)d_in[1]; p.ctx = (const float*)d_in[2]; p.c_ctx = (const float*)d_in[3];
    p.w_ada = (const float*)d_in[4]; p.b_ada = (const float*)d_in[5]; p.norm_g = (const float*)d_in[6]; p.w_in = (const float*)d_in[7];
    p.sgu_g = (const float*)d_in[8]; p.w_sp = (const float*)d_in[9]; p.b_sp = (const float*)d_in[10]; p.qg = (const float*)d_in[11];
    p.kg = (const float*)d_in[12]; p.rpb = (const float*)d_in[13]; p.w_out = (const float*)d_in[14];
    p.out = (float*)d_out;
    unsigned char* w = (unsigned char*)d_ws; size_t off = 0;
    auto take = [&](size_t bytes) { unsigned char* r = w + off; off += (bytes + 255) & ~(size_t)255; return r; };
    p.modp = (float*)take((size_t)32 * 9 * 3072 * 4);
    p.gatef = (float*)take((size_t)8 * 1024 * 4);
    p.H = (bf16_t*)take((size_t)MROWS * 1024 * 2);
    p.WinT = (bf16_t*)take((size_t)3584 * 1024 * 2);
    p.WoutT = (bf16_t*)take((size_t)1024 * 1024 * 2);
    p.Wsp = (bf16_t*)take((size_t)4 * 128 * 128 * 2);
    p.U = (bf16_t*)take((size_t)MROWS * 512 * 2); p.Vg = (bf16_t*)take((size_t)MROWS * 512 * 2); p.G = (bf16_t*)take((size_t)MROWS * 512 * 2);
    p.Q = (bf16_t*)take((size_t)MROWS * 512 * 2); p.Kn = (bf16_t*)take((size_t)MROWS * 512 * 2); p.BG = (bf16_t*)take((size_t)MROWS * 512 * 2);
    p.Vt = (bf16_t*)take((size_t)8 * 8 * 64 * LTOT * 2);
    p.MIX = (bf16_t*)take((size_t)32768 * 1024 * 2);
    if (off > ws_size) { fprintf(stderr, "kernel_launch: workspace too small (%zu needed, %zu given)\n", off, ws_size); return; }
#if ONE_LAUNCH
    static int grid = 0;
    if (grid == 0) {
        int dev = 0, cus = 0, per_cu = 0;
        hipGetDevice(&dev); hipDeviceGetAttribute(&cus, hipDeviceAttributeMultiprocessorCount, dev);
        hipFuncSetAttribute((const void*)k_mega, hipFuncAttributeMaxDynamicSharedMemorySize, LDS_BYTES);
        hipOccupancyMaxActiveBlocksPerMultiprocessor(&per_cu, (const void*)k_mega, 512, LDS_BYTES);
        if (per_cu < 1) { fprintf(stderr, "kernel_launch: occupancy query says %d blocks per CU\n", per_cu); per_cu = 1; }
        if (per_cu > 1) per_cu = 1;
        grid = cus * per_cu;
    }
    void* args[] = {&p};
    hipError_t e = hipLaunchCooperativeKernel((const void*)k_mega, dim3(grid), dim3(512), args, LDS_BYTES, stream);
    if (e != hipSuccess) fprintf(stderr, "cooperative launch failed: %s (grid %d)\n", hipGetErrorString(e), grid);
#else
    static int inited = 0;
    if (!inited) {
        hipFuncSetAttribute((const void*)k_phase<0>, hipFuncAttributeMaxDynamicSharedMemorySize, LDS_BYTES);
        hipFuncSetAttribute((const void*)k_phase<1>, hipFuncAttributeMaxDynamicSharedMemorySize, LDS_BYTES);
        hipFuncSetAttribute((const void*)k_phase<2>, hipFuncAttributeMaxDynamicSharedMemorySize, LDS_BYTES);
        hipFuncSetAttribute((const void*)k_phase<3>, hipFuncAttributeMaxDynamicSharedMemorySize, LDS_BYTES);
        hipFuncSetAttribute((const void*)k_phase<4>, hipFuncAttributeMaxDynamicSharedMemorySize, LDS_BYTES);
        inited = 1;
    }
    const int grid = 256;
    hipLaunchKernelGGL(k_phase<0>, dim3(grid), dim3(512), LDS_BYTES, stream, p);
    hipLaunchKernelGGL(k_phase<1>, dim3(grid), dim3(512), LDS_BYTES, stream, p);
    hipLaunchKernelGGL(k_phase<2>, dim3(grid), dim3(512), LDS_BYTES, stream, p);
    hipLaunchKernelGGL(k_phase<3>, dim3(grid), dim3(512), LDS_BYTES, stream, p);
    hipLaunchKernelGGL(k_phase<4>, dim3(grid), dim3(512), LDS_BYTES, stream, p);
#endif
}
```

```cpp
#include <hip/hip_runtime.h>
#include <hip/hip_cooperative_groups.h>
#include <cstdio>
namespace cg = cooperative_groups;

#ifndef ONE_LAUNCH
#define ONE_LAUNCH 1
#endif
#ifndef PROBE_PH
#define PROBE_PH -1
#endif

#define LAS __attribute__((address_space(3)))
typedef unsigned short bf16_t;
typedef short bf16x8 __attribute__((ext_vector_type(8)));
typedef short s16x4 __attribute__((ext_vector_type(4)));
typedef float f32x4 __attribute__((ext_vector_type(4)));
typedef float f32x2 __attribute__((ext_vector_type(2)));
typedef unsigned u32x4 __attribute__((ext_vector_type(4)));
typedef unsigned u32x2 __attribute__((ext_vector_type(2)));

constexpr int LTOT = 4352;
constexpr int MROWS = 8 * LTOT;
constexpr float LOG2E = 1.4426950408889634f;
constexpr float EPS = 1e-6f;
constexpr int LDS_BYTES = 131072 + 16;

struct Params {
    const float *x, *c, *ctx, *c_ctx, *w_ada, *b_ada, *norm_g, *w_in, *sgu_g, *w_sp, *b_sp, *qg, *kg, *rpb, *w_out;
    float* out;
    float* modp;
    float* gatef;
    bf16_t* H;
    bf16_t* WinT;
    bf16_t* WoutT;
    bf16_t* Wsp;
    bf16_t *U, *Vg, *G, *Q, *Kn, *BG;
    bf16_t* Vt;
    bf16_t* MIX;
    unsigned* bar;
};

__device__ __forceinline__ unsigned cvt_pk_bf16(float lo, float hi) { unsigned r; asm volatile("v_cvt_pk_bf16_f32 %0, %1, %2" : "=v"(r) : "v"(lo), "v"(hi)); return r; }
__device__ __forceinline__ float bf_lo(unsigned w) { return __uint_as_float(w << 16); }
__device__ __forceinline__ float bf_hi(unsigned w) { return __uint_as_float(w & 0xffff0000u); }
__device__ __forceinline__ float silu_f(float v) { return v * __builtin_amdgcn_rcpf(1.0f + __expf(-v)); }
__device__ __forceinline__ float red_max_fq(float x) {
    const unsigned u = __float_as_uint(x); const auto a = __builtin_amdgcn_permlane16_swap(u, u, false, false);
    const float y = fmaxf(__uint_as_float(a[0]), __uint_as_float(a[1]));
    const unsigned v = __float_as_uint(y); const auto c = __builtin_amdgcn_permlane32_swap(v, v, false, false);
    return fmaxf(__uint_as_float(c[0]), __uint_as_float(c[1]));
}
__device__ __forceinline__ float red_sum_fq(float x) {
    const unsigned u = __float_as_uint(x); const auto a = __builtin_amdgcn_permlane16_swap(u, u, false, false);
    const float y = __uint_as_float(a[0]) + __uint_as_float(a[1]);
    const unsigned v = __float_as_uint(y); const auto c = __builtin_amdgcn_permlane32_swap(v, v, false, false);
    return __uint_as_float(c[0]) + __uint_as_float(c[1]);
}

namespace pg8 {
constexpr int BM = 256, BK = 64, HALF = 128, HTB = HALF * BK * 2, STAGE_BYTES = 8 * HTB, NXCD = 8, WGM = 8;
__host__ __device__ __forceinline__ int lds_byte(int r, int c) { const int st = (r >> 4) * 2 + (c >> 5), rr = r & 15, cc = c & 31, ob = rr * 64 + cc * 2; return st * 1024 + (ob ^ (((ob >> 9) & 1) << 5)); }
__host__ __device__ __forceinline__ void stage_rc(int b, int& R, int& C) { const int st = b / 1024, sb = b % 1024, swz = sb ^ (((sb >> 9) & 1) << 5); R = (st >> 1) * 16 + swz / 64; C = (st & 1) * 32 + (swz % 64) / 2; }
__host__ __device__ __forceinline__ int perm32(int rho) { const int n = rho >> 4, i = rho & 15; return 8 * (i >> 2) + 4 * n + (i & 3); }

struct Unit { int pm, pn; };
struct Gemm { const bf16_t* A; const bf16_t* Bt; int M, N, K; };

struct StaticOrder {
    int nM, nN, nwg, G, c;
    __host__ __device__ void init(int M, int N, int G_, int c_) { nM = M / BM; nN = N / BM; nwg = nM * nN; G = G_; c = c_; }
    __host__ __device__ bool next(int i, Unit& u) const {
        const long L = (long)i * G + c; if (L >= nwg) return false;
        int wgid = (int)L; { const int q = nwg / NXCD, r = nwg % NXCD, xcd = wgid % NXCD, off = wgid / NXCD; wgid = (xcd < r ? xcd * (q + 1) : r * (q + 1) + (xcd - r) * q) + off; }
        const int nig = WGM * nN, gid = wgid / nig, fm = gid * WGM, gsz = (nM - fm) < WGM ? (nM - fm) : WGM;
        u.pm = fm + ((wgid % nig) % gsz); u.pn = (wgid % nig) / gsz; return true;
    }
    __device__ __forceinline__ void a_ready(const Unit&) const {}
    __device__ __forceinline__ void done(const Unit&) const {}
};

__device__ __forceinline__ f32x2 gelu_pk(f32x2 v) {
    const f32x2 av = __builtin_elementwise_abs(v), d = av * 0.2316418882f + 1.0f;
    f32x2 t; t.x = __builtin_amdgcn_rcpf(d.x); t.y = __builtin_amdgcn_rcpf(d.y);
    f32x2 q = t * 0.5307027145f + (-0.7265760135f); q = q * t + 0.7107068705f; q = q * t + (-0.142248368f); q = q * t + 0.127414796f; q = q * t;
    const f32x2 s = (v * v) * (-0.72134752044f);
    f32x2 e; e.x = __builtin_amdgcn_exp2f(s.x); e.y = __builtin_amdgcn_exp2f(s.y);
    const f32x2 m = v * (q * e), r = v - m;
    f32x2 o; o.x = v.x < 0.f ? m.x : r.x; o.y = v.y < 0.f ? m.y : r.y; return o;
}

template <class Epi, class Sched>
__device__ __forceinline__ void gemm_phase(LAS unsigned char* lds, const Gemm g, const Sched& S, const Epi& E) {
    int tid_ = threadIdx.x; asm volatile("" : "+v"(tid_));
    const int tid = tid_, wid = __builtin_amdgcn_readfirstlane(tid >> 6), lane = tid & 63, wr = wid >> 2, wc = wid & 3, fr = lane & 15, fq = lane >> 4;
    const int K = g.K, nt = K / BK;
    unsigned voffA[2], voffB[2];
#pragma unroll
    for (int i = 0; i < 2; ++i) { int R, C; stage_rc(tid * 16 + i * 8192, R, C); const int Rb = Epi::PERM ? ((R & ~31) + perm32(R & 31)) : R;
        voffA[i] = (unsigned)(R * K + C) * 2u; voffB[i] = (unsigned)(Rb * K + C) * 2u; }
    const size_t kstep = (size_t)(BK * 2);
    const size_t hstep = (size_t)HALF * K * 2;
    const size_t tstep = 2 * hstep;
    const unsigned ldsw = (unsigned)wid * 1024u;
    const int aoff = lds_byte(wr * 64 + fr, fq * 8), boff = lds_byte(wc * 32 + fr, fq * 8);
#define PG8_SA(b, h) (((b) * 2 + (h)) * HTB)
#define PG8_SB(b, h) ((4 + (b) * 2 + (h)) * HTB)
#define PG8_STAGE(bufoff, gbase, voff) do { _Pragma("unroll") for (int _i = 0; _i < 2; ++_i) \
        __builtin_amdgcn_global_load_lds((const unsigned*)((const char*)(gbase) + (voff)[_i]), (LAS unsigned*)(lds + (bufoff) + ldsw + _i * 8192), 16, 0, 0); } while (0)
#define PG8_LDA(dst, b, h) do { _Pragma("unroll") for (int m = 0; m < 4; ++m) _Pragma("unroll") for (int k = 0; k < 2; ++k) dst[m][k] = *(const LAS bf16x8*)(lds + PG8_SA(b, h) + aoff + m * 2048 + k * 1024); } while (0)
#define PG8_LDB(dst, b, h) do { _Pragma("unroll") for (int n = 0; n < 2; ++n) _Pragma("unroll") for (int k = 0; k < 2; ++k) dst[n][k] = *(const LAS bf16x8*)(lds + PG8_SB(b, h) + boff + n * 2048 + k * 1024); } while (0)
#define PG8_MMA(ai, bj, At, Bt) do { __builtin_amdgcn_s_setprio(1); _Pragma("unroll") for (int m = 0; m < 4; ++m) _Pragma("unroll") for (int n = 0; n < 2; ++n) _Pragma("unroll") for (int k = 0; k < 2; ++k) \
        acc[ai][bj][m][n] = __builtin_amdgcn_mfma_f32_16x16x32_bf16(Bt[n][k], At[m][k], acc[ai][bj][m][n], 0, 0, 0); __builtin_amdgcn_s_setprio(0); } while (0)
#define PG8_WAIT_V(n) asm volatile("s_waitcnt vmcnt(" #n ")" ::: "memory")
#define PG8_WAIT_L(n) asm volatile("s_waitcnt lgkmcnt(" #n ")" ::: "memory")
#define PG8_BAR __builtin_amdgcn_s_barrier()
#define PG8_SCHED __builtin_amdgcn_sched_barrier(0)
    Unit cur, nxt; int ui = 0;
    if (!S.next(0, cur)) return;
    f32x4 acc[2][2][4][2];
#pragma unroll
    for (int a = 0; a < 2; ++a)
#pragma unroll
        for (int b = 0; b < 2; ++b)
#pragma unroll
            for (int m = 0; m < 4; ++m)
#pragma unroll
                for (int n = 0; n < 2; ++n) acc[a][b][m][n] = (f32x4){0.f, 0.f, 0.f, 0.f};
    bf16x8 At[4][2], B0[2][2], B1[2][2];
    const char* cA = (const char*)g.A + (size_t)cur.pm * tstep; const char* cB = (const char*)g.Bt + (size_t)cur.pn * tstep;
    S.a_ready(cur);
    PG8_STAGE(PG8_SB(0, 0), cB, voffB); PG8_STAGE(PG8_SA(0, 0), cA, voffA); PG8_STAGE(PG8_SB(0, 1), cB + hstep, voffB); PG8_STAGE(PG8_SA(0, 1), cA + hstep, voffA);
    if (wr == 1) PG8_BAR;
    PG8_WAIT_V(4); PG8_BAR;
    PG8_STAGE(PG8_SB(1, 0), cB + kstep, voffB); PG8_STAGE(PG8_SA(1, 0), cA + kstep, voffA); PG8_STAGE(PG8_SB(1, 1), cB + hstep + kstep, voffB);
    PG8_WAIT_V(6); PG8_BAR;
    for (;;) {
        const bool has_next = S.next(ui + 1, nxt);
        const char* nA = has_next ? (const char*)g.A + (size_t)nxt.pm * tstep : cA; const char* nB = has_next ? (const char*)g.Bt + (size_t)nxt.pn * tstep : cB;
        for (int t = 0; t < nt; t += 2) {
            const bool last = (t == nt - 2);
            const char* a1 = cA + (size_t)(t + 1) * kstep;
            const char* a2 = last ? nA : cA + (size_t)(t + 2) * kstep; const char* b2 = last ? nB : cB + (size_t)(t + 2) * kstep;
            const char* a3 = a2 + kstep; const char* b3 = b2 + kstep;
            if (last && has_next) S.a_ready(nxt);
            PG8_LDB(B0, 0, 0); PG8_SCHED; PG8_LDA(At, 0, 0); PG8_STAGE(PG8_SA(1, 1), a1 + hstep, voffA);
            PG8_WAIT_L(8); PG8_BAR; PG8_WAIT_L(0); PG8_MMA(0, 0, At, B0); PG8_BAR; PG8_SCHED;
            PG8_LDB(B1, 0, 1); PG8_STAGE(PG8_SB(0, 0), b2, voffB);
            PG8_BAR; PG8_WAIT_L(0); PG8_MMA(0, 1, At, B1); PG8_BAR;
            PG8_LDA(At, 0, 1); PG8_STAGE(PG8_SA(0, 0), a2, voffA);
            PG8_BAR; PG8_WAIT_L(0); PG8_MMA(1, 0, At, B0); PG8_BAR; PG8_SCHED;
            PG8_STAGE(PG8_SB(0, 1), b2 + hstep, voffB);
            PG8_WAIT_V(6); PG8_BAR; PG8_MMA(1, 1, At, B1); PG8_BAR;
            PG8_LDB(B0, 1, 0); PG8_SCHED; PG8_LDA(At, 1, 0); PG8_STAGE(PG8_SA(0, 1), a2 + hstep, voffA);
            PG8_WAIT_L(8); PG8_BAR; PG8_WAIT_L(0); PG8_MMA(0, 0, At, B0); PG8_BAR; PG8_SCHED;
            PG8_LDB(B1, 1, 1); PG8_STAGE(PG8_SB(1, 0), b3, voffB);
            PG8_BAR; PG8_WAIT_L(0); PG8_MMA(0, 1, At, B1); PG8_BAR;
            PG8_LDA(At, 1, 1); PG8_STAGE(PG8_SA(1, 0), a3, voffA);
            PG8_BAR; PG8_WAIT_L(0); PG8_MMA(1, 0, At, B0); PG8_BAR; PG8_SCHED;
            PG8_STAGE(PG8_SB(1, 1), b3 + hstep, voffB);
            PG8_WAIT_V(6); PG8_BAR; PG8_MMA(1, 1, At, B1); PG8_BAR;
        }
        E(acc, cur, wr, wc, fr, fq); S.done(cur);
        if (!has_next) break;
#pragma unroll
        for (int a = 0; a < 2; ++a)
#pragma unroll
            for (int b = 0; b < 2; ++b)
#pragma unroll
                for (int m = 0; m < 4; ++m)
#pragma unroll
                    for (int n = 0; n < 2; ++n) acc[a][b][m][n] = (f32x4){0.f, 0.f, 0.f, 0.f};
        cur = nxt; cA = nA; cB = nB; ++ui;
    }
    PG8_WAIT_V(0);
    if (wr == 0) PG8_BAR;
    PG8_BAR;
#undef PG8_SA
#undef PG8_SB
#undef PG8_STAGE
#undef PG8_LDA
#undef PG8_LDB
#undef PG8_MMA
#undef PG8_WAIT_V
#undef PG8_WAIT_L
#undef PG8_BAR
#undef PG8_SCHED
}
}

struct Sched1 {
    int G, c;
    __device__ bool next(int i, pg8::Unit& u) const {
        const int L = i * G + c; if (L >= 1792) return false;
        const int wgid = (L & 7) * 224 + (L >> 3);
        const int gid = wgid / 112, rem = wgid - gid * 112;
        const int pml = gid * 8 + (rem & 7);
        u.pm = pml + (pml >> 4); u.pn = rem >> 3;
        return true;
    }
    __device__ __forceinline__ void a_ready(const pg8::Unit&) const {}
    __device__ __forceinline__ void done(const pg8::Unit&) const {}
};

struct Epi1 {
    static constexpr bool PERM = true;
    bf16_t *U, *Vg, *G, *Q, *Kn, *BG, *Vt; const float *qg, *kg;
    __device__ __forceinline__ void operator()(const f32x4 (&acc)[2][2][4][2], const pg8::Unit& u, int wr, int wc, int fr, int fq) const {
        const int type = u.pn >> 1, half = u.pn & 1;
        const size_t row0 = (size_t)u.pm * 256 + wr * 64 + fr;
        if (type == 5) {
            const int b = u.pm / 17, t0 = (u.pm - b * 17) * 256 + wr * 64 + fr;
#pragma unroll
            for (int bj = 0; bj < 2; ++bj)
#pragma unroll
                for (int n = 0; n < 2; ++n)
#pragma unroll
                    for (int e = 0; e < 4; ++e) {
                        const int cc = half * 256 + bj * 128 + wc * 32 + 8 * fq + 4 * n + e;
                        bf16_t* base = Vt + ((size_t)b * 512 + cc) * LTOT + t0;
#pragma unroll
                        for (int ai = 0; ai < 2; ++ai)
#pragma unroll
                            for (int m = 0; m < 4; ++m) base[ai * 128 + m * 16] = (bf16_t)(cvt_pk_bf16(acc[ai][bj][m][n][e], 0.f) & 0xffffu);
                    }
        } else if (type == 3 || type == 4) {
            const float* gw = (type == 3) ? qg : kg; const float mul = (type == 3) ? 0.125f * LOG2E : 1.0f;
            bf16_t* O = (type == 3) ? Q : Kn;
            f32x4 gv[2][2];
#pragma unroll
            for (int bj = 0; bj < 2; ++bj)
#pragma unroll
                for (int n = 0; n < 2; ++n) gv[bj][n] = *(const f32x4*)(gw + bj * 32 + 8 * fq + 4 * n) * mul;
            const int colbase = half * 256 + wc * 64 + 8 * fq;
#pragma unroll
            for (int ai = 0; ai < 2; ++ai)
#pragma unroll
                for (int m = 0; m < 4; ++m) {
                    float ss = 0.f;
#pragma unroll
                    for (int bj = 0; bj < 2; ++bj)
#pragma unroll
                        for (int n = 0; n < 2; ++n) { const f32x4 v = acc[ai][bj][m][n]; ss += (v[0] * v[0] + v[1] * v[1]) + (v[2] * v[2] + v[3] * v[3]); }
                    ss = red_sum_fq(ss);
                    const float rstd = __builtin_amdgcn_rsqf(ss * (1.0f / 64.0f) + EPS);
                    bf16_t* rowp = O + (row0 + ai * 128 + m * 16) * 512 + colbase;
#pragma unroll
                    for (int bj = 0; bj < 2; ++bj) {
                        const f32x4 v0 = acc[ai][bj][m][0] * rstd * gv[bj][0], v1 = acc[ai][bj][m][1] * rstd * gv[bj][1];
                        u32x4 w; w.x = cvt_pk_bf16(v0[0], v0[1]); w.y = cvt_pk_bf16(v0[2], v0[3]); w.z = cvt_pk_bf16(v1[0], v1[1]); w.w = cvt_pk_bf16(v1[2], v1[3]);
                        *(u32x4*)(rowp + bj * 32) = w;
                    }
                }
        } else {
            bf16_t* O = (type == 0) ? U : (type == 1) ? Vg : (type == 2) ? G : BG;
            const int col0 = half * 256 + wc * 32 + 8 * fq;
            const bool is_gelu = type <= 1;
#pragma unroll
            for (int ai = 0; ai < 2; ++ai)
#pragma unroll
                for (int m = 0; m < 4; ++m) {
                    bf16_t* rowp = O + (row0 + ai * 128 + m * 16) * 512 + col0;
#pragma unroll
                    for (int bj = 0; bj < 2; ++bj) {
                        f32x4 v0 = acc[ai][bj][m][0], v1 = acc[ai][bj][m][1];
                        if (is_gelu) {
                            const f32x2 a = pg8::gelu_pk((f32x2){v0[0], v0[1]}), b = pg8::gelu_pk((f32x2){v0[2], v0[3]}), c = pg8::gelu_pk((f32x2){v1[0], v1[1]}), d = pg8::gelu_pk((f32x2){v1[2], v1[3]});
                            v0 = (f32x4){a.x, a.y, b.x, b.y}; v1 = (f32x4){c.x, c.y, d.x, d.y};
                        } else {
#pragma unroll
                            for (int j = 0; j < 4; ++j) { v0[j] = silu_f(v0[j]); v1[j] = silu_f(v1[j]); }
                        }
                        u32x4 w; w.x = cvt_pk_bf16(v0[0], v0[1]); w.y = cvt_pk_bf16(v0[2], v0[3]); w.z = cvt_pk_bf16(v1[0], v1[1]); w.w = cvt_pk_bf16(v1[2], v1[3]);
                        *(u32x4*)(rowp + bj * 128) = w;
                    }
                }
        }
    }
};

struct EpiOut {
    static constexpr bool PERM = false;
    const float* x; const float* gatef; float* out;
    __device__ __forceinline__ void operator()(const f32x4 (&acc)[2][2][4][2], const pg8::Unit& u, int wr, int wc, int fr, int fq) const {
        const size_t row0 = (size_t)u.pm * 256 + wr * 64 + fr; const int col0 = u.pn * 256 + wc * 32 + 4 * fq; const int b = u.pm >> 4;
        f32x4 gv[2][2];
#pragma unroll
        for (int bj = 0; bj < 2; ++bj)
#pragma unroll
            for (int n = 0; n < 2; ++n) gv[bj][n] = *(const f32x4*)(gatef + b * 1024 + col0 + bj * 128 + n * 16);
#pragma unroll
        for (int ai = 0; ai < 2; ++ai) {
            f32x4 xv[4][2][2];
#pragma unroll
            for (int m = 0; m < 4; ++m)
#pragma unroll
                for (int bj = 0; bj < 2; ++bj)
#pragma unroll
                    for (int n = 0; n < 2; ++n) xv[m][bj][n] = __builtin_nontemporal_load((const f32x4*)(x + (row0 + ai * 128 + m * 16) * 1024 + col0 + bj * 128 + n * 16));
#pragma unroll
            for (int m = 0; m < 4; ++m)
#pragma unroll
                for (int bj = 0; bj < 2; ++bj)
#pragma unroll
                    for (int n = 0; n < 2; ++n)
                        *(f32x4*)(out + (row0 + ai * 128 + m * 16) * 1024 + col0 + bj * 128 + n * 16) = xv[m][bj][n] + gv[bj][n] * acc[ai][bj][m][n];
        }
    }
};

__device__ __forceinline__ int win_actual_col(int n) {
    if (n < 1536 || n >= 2560) return n;
    const int g = n & 255;
    return (n & ~255) + ((g >> 5) & 3) * 64 + (g >> 7) * 32 + (g & 31);
}
struct TrItem { const float* src; bf16_t* dst; int N; };
__device__ __forceinline__ TrItem tr_item(const Params& p, int r, int tid) {
    TrItem t; const int kr = tid >> 3, ch = tid & 7;
    if (r < 896) { const int n0 = (r >> 4) * 64, k0 = (r & 15) * 64; t.N = 3584; t.src = p.w_in + (size_t)(k0 + kr) * 3584 + win_actual_col(n0 + ch * 8); t.dst = p.WinT + (size_t)n0 * 1024 + k0; }
    else { const int q = r - 896, n0 = (q >> 4) * 64, k0 = (q & 15) * 64; t.N = 1024; t.src = p.w_out + (size_t)(k0 + kr) * 1024 + n0 + ch * 8; t.dst = p.WoutT + (size_t)n0 * 1024 + k0; }
    return t;
}
struct MapCtxCols { __device__ __forceinline__ int operator()(int q) const { return 512 + q; } };
struct MapRest    { __device__ __forceinline__ int operator()(int q) const { return q < 512 ? q : q + 256; } };
struct MapAll     { __device__ __forceinline__ int operator()(int q) const { return q; } };
template <class Map>
__device__ __forceinline__ void transpose_items(const Params& p, LAS float* fl, int tid, int first, int step, int count, Map map) {
    const int kr = tid >> 3, ch = tid & 7;
    f32x4 ra0, rb0, ra1, rb1; TrItem c0{}, c1{};
    int q = first, par = 0;
    if (q < count) { c0 = tr_item(p, map(q), tid); ra0 = *(const f32x4*)c0.src; rb0 = *(const f32x4*)(c0.src + 4); }
    if (q + step < count) { c1 = tr_item(p, map(q + step), tid); ra1 = *(const f32x4*)c1.src; rb1 = *(const f32x4*)(c1.src + 4); }
    while (q < count) {
        const bool two = q + step < count;
        LAS float* tl0 = fl + 4096 + par * (2 * 64 * 65); LAS float* tl1 = tl0 + 64 * 65;
        { LAS float* d = tl0 + (ch * 8) * 65 + kr;
          d[0] = ra0[0]; d[65] = ra0[1]; d[130] = ra0[2]; d[195] = ra0[3]; d[260] = rb0[0]; d[325] = rb0[1]; d[390] = rb0[2]; d[455] = rb0[3]; }
        if (two) { LAS float* d = tl1 + (ch * 8) * 65 + kr;
          d[0] = ra1[0]; d[65] = ra1[1]; d[130] = ra1[2]; d[195] = ra1[3]; d[260] = rb1[0]; d[325] = rb1[1]; d[390] = rb1[2]; d[455] = rb1[3]; }
        __syncthreads();
        const int qn = q + 2 * step; const TrItem m0 = c0, m1 = c1;
        if (qn < count) { c0 = tr_item(p, map(qn), tid); ra0 = *(const f32x4*)c0.src; rb0 = *(const f32x4*)(c0.src + 4); }
        if (qn + step < count) { c1 = tr_item(p, map(qn + step), tid); ra1 = *(const f32x4*)c1.src; rb1 = *(const f32x4*)(c1.src + 4); }
        { const LAS float* sp = tl0 + kr * 65 + ch * 8;
          u32x4 w; w.x = cvt_pk_bf16(sp[0], sp[1]); w.y = cvt_pk_bf16(sp[2], sp[3]); w.z = cvt_pk_bf16(sp[4], sp[5]); w.w = cvt_pk_bf16(sp[6], sp[7]);
          *(u32x4*)(m0.dst + (size_t)kr * 1024 + ch * 8) = w; }
        if (two) { const LAS float* sp = tl1 + kr * 65 + ch * 8;
          u32x4 w; w.x = cvt_pk_bf16(sp[0], sp[1]); w.y = cvt_pk_bf16(sp[2], sp[3]); w.z = cvt_pk_bf16(sp[4], sp[5]); w.w = cvt_pk_bf16(sp[6], sp[7]);
          *(u32x4*)(m1.dst + (size_t)kr * 1024 + ch * 8) = w; }
        q = qn; par ^= 1;
    }
}
__device__ __forceinline__ void phase0(const Params& p, LAS unsigned char* lds, int tid) {
    LAS float* fl = (LAS float*)lds;
    for (int it = blockIdx.x; it < 192; it += gridDim.x) {
        const int cgi = it >> 4, ks = it & 15;
        __syncthreads();
        { float cvv[2];
#pragma unroll
          for (int u = 0; u < 2; ++u) { const int i = min(tid + 512 * u, 575), r = i >> 6, k = ks * 64 + (i & 63); const float* src = (r < 8) ? p.c + r * 1024 + k : p.c_ctx + k; cvv[u] = *src; }
#pragma unroll
          for (int u = 0; u < 2; ++u) { const int i = tid + 512 * u; if (i < 576) fl[(i & 63) * 12 + (i >> 6)] = cvv[u] / (1.0f + __expf(-cvv[u])); } }
        __syncthreads();
        const int col = cgi * 256 + (tid & 255), kh = tid >> 8;
        float a0 = 0.f, a1 = 0.f, a2 = 0.f, a3 = 0.f, a4 = 0.f, a5 = 0.f, a6 = 0.f, a7 = 0.f, a8 = 0.f;
        const float* wp = p.w_ada + (size_t)(ks * 64 + kh * 32) * 3072 + col;
#pragma unroll
        for (int kk = 0; kk < 32; ++kk) {
            const int kl = kh * 32 + kk; const float w = __builtin_nontemporal_load(wp + (size_t)kk * 3072);
            const LAS f32x4* f = (const LAS f32x4*)(fl + kl * 12); const f32x4 s0 = f[0], s1 = f[1]; const float s8 = fl[kl * 12 + 8];
            a0 += s0[0] * w; a1 += s0[1] * w; a2 += s0[2] * w; a3 += s0[3] * w; a4 += s1[0] * w;
            a5 += s1[1] * w; a6 += s1[2] * w; a7 += s1[3] * w; a8 += s8 * w;
        }
        LAS float* ex = fl + 1536; const int tc = tid & 255;
        if (kh == 1) { ex[tc] = a0; ex[256 + tc] = a1; ex[512 + tc] = a2; ex[768 + tc] = a3; ex[1024 + tc] = a4; ex[1280 + tc] = a5; ex[1536 + tc] = a6; ex[1792 + tc] = a7; ex[2048 + tc] = a8; }
        __syncthreads();
        if (kh == 0) { float* o = p.modp + (size_t)(ks * 9) * 3072 + col;
            o[0] = a0 + ex[tc]; o[3072] = a1 + ex[256 + tc]; o[2 * 3072] = a2 + ex[512 + tc]; o[3 * 3072] = a3 + ex[768 + tc]; o[4 * 3072] = a4 + ex[1024 + tc];
            o[5 * 3072] = a5 + ex[1280 + tc]; o[6 * 3072] = a6 + ex[1536 + tc]; o[7 * 3072] = a7 + ex[1792 + tc]; o[8 * 3072] = a8 + ex[2048 + tc]; }
    }
    __syncthreads();
    if (gridDim.x == 256) { if (blockIdx.x >= 192) transpose_items(p, fl, tid, (int)blockIdx.x - 192, 64, 256, MapCtxCols()); }
    else transpose_items(p, fl, tid, (int)blockIdx.x, (int)gridDim.x, 1152, MapAll());
    for (int i = blockIdx.x * 512 + tid; i < 32768; i += gridDim.x * 512) { const float a = p.w_sp[2 * i], b = p.w_sp[2 * i + 1]; ((unsigned*)p.Wsp)[i] = cvt_pk_bf16(a, b); }
}

#define XB_TMO      128
#define XB_XCNT(j)  (256  + 64 * (j))
#define XB_XSUB(j)  (1280 + 64 * (j))
#define XB_XGEN(j)  (2304 + 64 * (j))
#define XB_TOP      3328
#define XB_TOPGEN   3392
#define XCD_BAR_WORDS 3456
#define XB_SPIN_CAP (1u << 18)
__device__ __forceinline__ unsigned xb_ld(unsigned* p)              { return __hip_atomic_load(p, __ATOMIC_RELAXED, __HIP_MEMORY_SCOPE_AGENT); }
__device__ __forceinline__ unsigned xb_add(unsigned* p, unsigned v) { return __hip_atomic_fetch_add(p, v, __ATOMIC_RELAXED, __HIP_MEMORY_SCOPE_AGENT); }
__device__ __forceinline__ unsigned xb_xcc_id() { return (unsigned)__builtin_amdgcn_s_getreg((3 << 11) | 20) & 0xFu; }
#define XB_SPIN(cond, bar) do { unsigned _sp = 0; while (cond) { __builtin_amdgcn_s_sleep(1); \
    if ((++_sp & 255u) == 0u) { if (xb_ld(&(bar)[XB_TMO])) break; if (_sp > XB_SPIN_CAP) { atomicAdd(&(bar)[XB_TMO], 1u); break; } } } } while (0)
struct XcdBarrier { unsigned* bar; unsigned x; volatile LAS unsigned* st; };
__device__ __forceinline__ XcdBarrier xcd_barrier_post(unsigned* bar, volatile LAS unsigned* st) {
    XcdBarrier b; b.bar = bar; b.x = xb_xcc_id(); b.st = st;
    if (threadIdx.x == 0) (void)xb_add(&bar[XB_XCNT(b.x)], 1u);
    return b;
}
__device__ __forceinline__ void xcd_barrier_complete(unsigned* bar, unsigned x, unsigned& nloc, unsigned& nx) {
    const unsigned G = gridDim.x * gridDim.y * gridDim.z;
    unsigned sum, cnt, mine, sp = 0u;
    for (;;) {
        sum = 0u; cnt = 0u; mine = 0u;
#pragma unroll
        for (unsigned j = 0; j < 16; ++j) { const unsigned c = xb_ld(&bar[XB_XCNT(j)]); sum += c; cnt += (c > 0u) ? 1u : 0u; mine = (j == x) ? c : mine; }
        if (sum == G) break;
        __builtin_amdgcn_s_sleep(1);
        if ((++sp & 255u) == 0u) { if (xb_ld(&bar[XB_TMO])) break; if (sp > XB_SPIN_CAP) { atomicAdd(&bar[XB_TMO], 1u); break; } }
    }
    nloc = mine > 0u ? mine : 1u; nx = cnt > 0u ? cnt : 1u;
}
__device__ __forceinline__ void xcd_barrier(const XcdBarrier& b) {
    asm volatile("s_waitcnt vmcnt(0)" ::: "memory");
    __syncthreads();
    if (threadIdx.x == 0) {
        unsigned* bar = b.bar;
        __builtin_amdgcn_s_waitcnt(0);
        unsigned nloc = b.st[0], nx = b.st[1];
        if (nloc == 0u) { xcd_barrier_complete(bar, b.x, nloc, nx); b.st[0] = nloc; b.st[1] = nx; }
        const unsigned old = xb_add(&bar[XB_XSUB(b.x)], 1u);
        const unsigned gen = old / nloc;
        if (old + 1u == (gen + 1u) * nloc) {
            __builtin_amdgcn_fence(__ATOMIC_RELEASE, "agent");
            asm volatile("s_waitcnt vmcnt(0)" ::: "memory");
            const unsigned og = xb_add(&bar[XB_TOP], 1u);
            const unsigned tg = og / nx;
            if (og + 1u == (tg + 1u) * nx) xb_add(&bar[XB_TOPGEN], 1u);
            else XB_SPIN(xb_ld(&bar[XB_TOPGEN]) == tg, bar);
            __builtin_amdgcn_fence(__ATOMIC_ACQUIRE, "agent");
            xb_add(&bar[XB_XGEN(b.x)], 1u);
            asm volatile("s_waitcnt vmcnt(0)" ::: "memory");
        } else {
            XB_SPIN(xb_ld(&bar[XB_XGEN(b.x)]) == gen, bar);
            __builtin_amdgcn_fence(__ATOMIC_ACQUIRE, "agent");
            asm volatile("s_waitcnt vmcnt(0)" ::: "memory");
        }
    }
    __syncthreads();
}


struct SchedOne {
    int pm, pn;
    __device__ bool next(int i, pg8::Unit& u) const { if (i > 0) return false; u.pm = pm; u.pn = pn; return true; }
    __device__ __forceinline__ void a_ready(const pg8::Unit&) const {}
    __device__ __forceinline__ void done(const pg8::Unit&) const {}
};
__device__ __forceinline__ void rows4_load(f32x4 (&v)[4][4], const float* src0, int lane) {
#pragma unroll
    for (int rr = 0; rr < 4; ++rr)
#pragma unroll
        for (int j = 0; j < 4; ++j) v[rr][j] = __builtin_nontemporal_load((const f32x4*)(src0 + (size_t)rr * 1024 + j * 256 + lane * 4));
}
template <bool WT>
__device__ __forceinline__ void rows4_store(const f32x4 (&v)[4][4], bf16_t* dst0, const LAS float* sc_, const LAS float* sh_, int lane) {
#pragma unroll
    for (int rr = 0; rr < 4; ++rr) {
        float ss = 0.f;
#pragma unroll
        for (int j = 0; j < 4; ++j) ss += (v[rr][j][0] * v[rr][j][0] + v[rr][j][1] * v[rr][j][1]) + (v[rr][j][2] * v[rr][j][2] + v[rr][j][3] * v[rr][j][3]);
#pragma unroll
        for (int o = 1; o < 64; o <<= 1) ss += __shfl_xor(ss, o);
        const float rstd = __builtin_amdgcn_rsqf(ss * (1.0f / 1024.0f) + EPS);
        bf16_t* drp = dst0 + (size_t)rr * 1024;
#pragma unroll
        for (int j = 0; j < 4; ++j) {
            const int k = j * 256 + lane * 4;
            const f32x4 a = *(const LAS f32x4*)(sc_ + k), sv = *(const LAS f32x4*)(sh_ + k);
            const f32x4 hv = v[rr][j] * rstd * a + sv;
            u32x2 w; w.x = cvt_pk_bf16(hv[0], hv[1]); w.y = cvt_pk_bf16(hv[2], hv[3]);
            if (WT) __hip_atomic_store((unsigned long long*)(drp + k), (unsigned long long)w.x | ((unsigned long long)w.y << 32), __ATOMIC_RELAXED, __HIP_MEMORY_SCOPE_AGENT);
            else *(u32x2*)(drp + k) = w;
        }
    }
}
template <bool WT>
__device__ __forceinline__ void norm_rows4(const float* src0, bf16_t* dst0, const LAS float* sc_, const LAS float* sh_, int lane) {
    f32x4 v[4][4]; rows4_load(v, src0, lane); rows4_store<WT>(v, dst0, sc_, sh_, lane);
}
__device__ __forceinline__ void mod_tables(const Params& p, int row, LAS float* T, int tid, float* gate_out) {
    for (int k = tid; k < 1024; k += 512) {
        float s_sh = p.b_ada[k], s_sc = p.b_ada[1024 + k], s_g = p.b_ada[2048 + k];
#pragma unroll
        for (int ks = 0; ks < 16; ++ks) { const float* mb = p.modp + (size_t)(ks * 9 + row) * 3072 + k; s_sh += mb[0]; s_sc += mb[1024]; s_g += mb[2048]; }
        T[k] = p.norm_g[k] * (1.0f + s_sc); T[1024 + k] = s_sh;
        if (gate_out) gate_out[k] = s_g;
    }
}
__device__ __forceinline__ void phase1(const Params& p, LAS unsigned char* lds, int tid, int wid, int lane) {
    LAS float* T = (LAS float*)lds;
    if (blockIdx.x < 32) {
        const int i = blockIdx.x, cb = i >> 2;
        const int r0 = (i & 3) * 64 + wid * 8;
        f32x4 va[4][4], vb[4][4];
        rows4_load(va, p.ctx + ((size_t)cb * 256 + r0) * 1024, lane); rows4_load(vb, p.ctx + ((size_t)cb * 256 + r0 + 4) * 1024, lane);
        mod_tables(p, 8, T, tid, nullptr);
        __syncthreads();
        rows4_store<true>(va, p.H + ((size_t)cb * LTOT + 4096 + r0) * 1024, T, T + 1024, lane);
        rows4_store<true>(vb, p.H + ((size_t)cb * LTOT + 4096 + r0 + 4) * 1024, T, T + 1024, lane);
        asm volatile("s_waitcnt vmcnt(0)" ::: "memory"); __syncthreads();
        if (tid == 0) {
            unsigned* cw = p.bar + XCD_BAR_WORDS + 64 * cb;
            (void)xb_add(cw, 1u);
            XB_SPIN(xb_ld(cw) < 4u, p.bar);
            __builtin_amdgcn_fence(__ATOMIC_ACQUIRE, "agent"); asm volatile("s_waitcnt vmcnt(0)" ::: "memory");
        }
        __syncthreads();
        pg8::Gemm g{p.H, p.WinT, MROWS, 3584, 1024};
        SchedOne S{cb * 17 + 16, 8 + (i & 3)};
        Epi1 E{p.U, p.Vg, p.G, p.Q, p.Kn, p.BG, p.Vt, p.qg, p.kg};
        pg8::gemm_phase<Epi1, SchedOne>(lds, g, S, E);
    } else {
        const int nb = (int)gridDim.x - 32, j = (int)blockIdx.x - 32;
        const int q0 = (int)(((long)j * 8192) / nb), q1 = (int)(((long)(j + 1) * 8192) / nb);
        const int b0 = q0 >> 10, b1 = (q1 - 1) >> 10;
        mod_tables(p, b0, T, tid, p.gatef + b0 * 1024);
        if (b1 != b0) mod_tables(p, b1, T + 2048, tid, p.gatef + b1 * 1024);
        __syncthreads();
        for (int q = q0 + wid; q < q1; q += 8) {
            const int bb = q >> 10; const LAS float* tab = (bb == b0) ? T : T + 2048;
            norm_rows4<false>(p.x + (size_t)q * 4096, p.H + ((size_t)bb * LTOT + (q & 1023) * 4) * 1024, tab, tab + 1024, lane);
        }
        if (gridDim.x == 256) transpose_items(p, T, tid, j, nb, 896, MapRest());
    }
}

__device__ __forceinline__ void sgu_phase(const Params& p, LAS unsigned char* lds, int tid, int wid, int lane) {
    constexpr int RS = 272;
    LAS float* gL = (LAS float*)lds;
    LAS float* bL = gL + 512;
    LAS unsigned char* wsL = lds + 32768; LAS unsigned char* vL = wsL + 128 * RS;
    const int fr = lane & 15, fq = lane >> 4;
    const int q = tid >> 2, qt = tid & 3;
    gL[tid] = p.sgu_g[tid]; bL[tid] = p.b_sp[tid];
    for (int unit = blockIdx.x; unit < 256; unit += gridDim.x) {
        const int b = unit >> 5, n = unit & 31;
        const size_t rowbase = (size_t)b * LTOT + n * 128, mixrow = (size_t)b * 4096 + n * 128;
        const size_t grow = rowbase + 16 * wid + fr;
        u32x4 wreg[4], vraw[4]; u32x2 uu[8], gg[8];
#pragma unroll
        for (int i = 0; i < 4; ++i) { const int idx = tid + 512 * i; wreg[i] = *(const u32x4*)(p.Wsp + (size_t)(idx >> 4) * 128 + (idx & 15) * 8);
            vraw[i] = *(const u32x4*)(p.Vg + (rowbase + q) * 512 + 32 * qt + 8 * i); }
#pragma unroll
        for (int cb = 0; cb < 8; ++cb) { const int colc = 16 * cb + 4 * fq; uu[cb] = *(const u32x2*)(p.U + grow * 512 + colc); gg[cb] = *(const u32x2*)(p.G + grow * 512 + colc); }
#pragma unroll 1
        for (int g = 0; g < 4; ++g) {
            __syncthreads();
#pragma unroll
            for (int i = 0; i < 4; ++i) { const int idx = tid + 512 * i; *(LAS u32x4*)(wsL + (idx >> 4) * RS + (idx & 15) * 16) = wreg[i]; }
            { float ss = 0.f;
#pragma unroll
              for (int i = 0; i < 4; ++i)
#pragma unroll
                  for (int j = 0; j < 4; ++j) { const float a = bf_lo(vraw[i][j]), bb = bf_hi(vraw[i][j]); ss += a * a + bb * bb; }
              ss += __shfl_xor(ss, 1); ss += __shfl_xor(ss, 2);
              const float rstd = __builtin_amdgcn_rsqf(ss * (1.0f / 128.0f) + EPS);
              const LAS float* gp = gL + g * 128 + 32 * qt;
#pragma unroll
              for (int i = 0; i < 4; ++i) { u32x4 w; const f32x4 g0 = *(const LAS f32x4*)(gp + 8 * i), g1 = *(const LAS f32x4*)(gp + 8 * i + 4);
                  w[0] = cvt_pk_bf16(bf_lo(vraw[i][0]) * rstd * g0[0], bf_hi(vraw[i][0]) * rstd * g0[1]); w[1] = cvt_pk_bf16(bf_lo(vraw[i][1]) * rstd * g0[2], bf_hi(vraw[i][1]) * rstd * g0[3]);
                  w[2] = cvt_pk_bf16(bf_lo(vraw[i][2]) * rstd * g1[0], bf_hi(vraw[i][2]) * rstd * g1[1]); w[3] = cvt_pk_bf16(bf_lo(vraw[i][3]) * rstd * g1[2], bf_hi(vraw[i][3]) * rstd * g1[3]);
                  *(LAS u32x4*)(vL + q * RS + 64 * qt + 16 * i) = w; } }
            __syncthreads();
            u32x2 uun[8], ggn[8];
            if (g < 3) {
#pragma unroll
                for (int i = 0; i < 4; ++i) { const int idx = tid + 512 * i; wreg[i] = *(const u32x4*)(p.Wsp + (size_t)((g + 1) * 128 + (idx >> 4)) * 128 + (idx & 15) * 8);
                    vraw[i] = *(const u32x4*)(p.Vg + (rowbase + q) * 512 + (g + 1) * 128 + 32 * qt + 8 * i); }
#pragma unroll
                for (int cb = 0; cb < 8; ++cb) { const int colc = (g + 1) * 128 + 16 * cb + 4 * fq; uun[cb] = *(const u32x2*)(p.U + grow * 512 + colc); ggn[cb] = *(const u32x2*)(p.G + grow * 512 + colc); }
            }
            bf16x8 wf[4];
#pragma unroll
            for (int ks = 0; ks < 4; ++ks) wf[ks] = *(const LAS bf16x8*)(wsL + (16 * wid + fr) * RS + ks * 64 + fq * 16);
            const float bias = bL[g * 128 + 16 * wid + fr];
            const int traddr = (8 * fq + ((lane & 15) >> 2)) * RS + 8 * (lane & 3);
            u32x2 wout[8];
#pragma unroll
            for (int cb = 0; cb < 8; ++cb) {
                f32x4 acc = {0.f, 0.f, 0.f, 0.f};
#pragma unroll
                for (int ks = 0; ks < 4; ++ks) {
                    const s16x4 a0 = __builtin_amdgcn_ds_read_tr16_b64_v4i16((LAS s16x4*)(vL + traddr + (32 * ks) * RS + 32 * cb));
                    const s16x4 a1 = __builtin_amdgcn_ds_read_tr16_b64_v4i16((LAS s16x4*)(vL + traddr + (32 * ks + 4) * RS + 32 * cb));
                    const bf16x8 a = {a0[0], a0[1], a0[2], a0[3], a1[0], a1[1], a1[2], a1[3]};
                    acc = __builtin_amdgcn_mfma_f32_16x16x32_bf16(a, wf[ks], acc, 0, 0, 0);
                }
                const float o0 = bf_lo(uu[cb].x) * (acc[0] + bias) * bf_lo(gg[cb].x), o1 = bf_hi(uu[cb].x) * (acc[1] + bias) * bf_hi(gg[cb].x);
                const float o2 = bf_lo(uu[cb].y) * (acc[2] + bias) * bf_lo(gg[cb].y), o3 = bf_hi(uu[cb].y) * (acc[3] + bias) * bf_hi(gg[cb].y);
                wout[cb].x = cvt_pk_bf16(o0, o1); wout[cb].y = cvt_pk_bf16(o2, o3);
            }
#pragma unroll
            for (int cb = 0; cb < 8; ++cb) *(u32x2*)(p.MIX + (mixrow + 16 * wid + fr) * 1024 + g * 128 + 16 * cb + 4 * fq) = wout[cb];
            if (g < 3) {
#pragma unroll
                for (int cb = 0; cb < 8; ++cb) { uu[cb] = uun[cb]; gg[cb] = ggn[cb]; }
            }
        }
    }
    __syncthreads();
}

struct KF { bf16x8 k00, k01, k10, k11; };
struct VF { bf16x8 v0, v1, v2, v3; };
__device__ __forceinline__ bf16x8 buf16(__amdgpu_buffer_rsrc_t r, unsigned voff, int soff) { union { u32x4 u; bf16x8 v; } x; x.u = __builtin_amdgcn_raw_buffer_load_b128(r, (int)voff, soff, 0); return x.v; }
__device__ __forceinline__ KF load_k(__amdgpu_buffer_rsrc_t rk, int so, unsigned kl) {
    KF r; r.k00 = buf16(rk, kl, so); r.k01 = buf16(rk, kl + 64u, so); r.k10 = buf16(rk, kl, so + 4096); r.k11 = buf16(rk, kl + 64u, so + 4096);
    return r;
}
__device__ __forceinline__ VF load_v(__amdgpu_buffer_rsrc_t rv, int so, unsigned vl) {
    VF r; r.v0 = buf16(rv, vl, so); r.v1 = buf16(rv, vl, so + 16 * LTOT * 2); r.v2 = buf16(rv, vl, so + 32 * LTOT * 2); r.v3 = buf16(rv, vl, so + 48 * LTOT * 2);
    return r;
}
template <bool CTX, bool ALL>
__device__ __forceinline__ void attn_step(KF& k, VF& v, __amdgpu_buffer_rsrc_t rk, __amdgpu_buffer_rsrc_t rv, int kb_next, int vb_next, unsigned kl, unsigned vl, const LAS unsigned char* qlds,
                                          f32x4 (&o)[4][4], const float m, float (&l)[4], unsigned act, const LAS float* tb0, int lo) {
#pragma unroll
    for (int tp = 0; tp < 4; tp += 2) {
        float s[2][8]; bf16x8 pfv[2];
#pragma unroll
        for (int u = 0; u < 2; ++u) {
            const int t = tp + u;
            if (!ALL && !((act >> t) & 1u)) continue;
            f32x4 s0 = {0.f, 0.f, 0.f, 0.f}, s1 = {0.f, 0.f, 0.f, 0.f};
            const bf16x8 qa = *(const LAS bf16x8*)(qlds + t * 2048), qb = *(const LAS bf16x8*)(qlds + t * 2048 + 1024);
            s0 = __builtin_amdgcn_mfma_f32_16x16x32_bf16(k.k00, qa, s0, 0, 0, 0); s0 = __builtin_amdgcn_mfma_f32_16x16x32_bf16(k.k01, qb, s0, 0, 0, 0);
            s1 = __builtin_amdgcn_mfma_f32_16x16x32_bf16(k.k10, qa, s1, 0, 0, 0); s1 = __builtin_amdgcn_mfma_f32_16x16x32_bf16(k.k11, qb, s1, 0, 0, 0);
#pragma unroll
            for (int e = 0; e < 4; ++e) { s[u][e] = s0[e]; s[u][4 + e] = s1[e]; }
        }
        if (tp == 2) k = load_k(rk, kb_next, kl);
#pragma unroll
        for (int u = 0; u < 2; ++u) {
            const int t = tp + u;
            if (!ALL && !((act >> t) & 1u)) continue;
            if (!CTX) {
                const LAS float* tb = tb0 - t * 64;
                float bv[8];
#pragma unroll
                for (int e = 0; e < 8; ++e) bv[e] = tb[e];
#pragma unroll
                for (int e = 0; e < 8; ++e) asm volatile("" : "+v"(bv[e]));
#pragma unroll
                for (int e = 0; e < 8; ++e) s[u][e] = ((unsigned)(e - lo) < 16u) ? s[u][e] + bv[e] : -1e30f;
            }
            float ps = 0.f;
#pragma unroll
            for (int e = 0; e < 8; ++e) { s[u][e] = __builtin_amdgcn_exp2f(s[u][e] - m); ps += s[u][e]; }
            l[t] += ps;
            union { u32x4 w; bf16x8 v; } pf;
            pf.w.x = cvt_pk_bf16(s[u][0], s[u][1]); pf.w.y = cvt_pk_bf16(s[u][2], s[u][3]); pf.w.z = cvt_pk_bf16(s[u][4], s[u][5]); pf.w.w = cvt_pk_bf16(s[u][6], s[u][7]);
            pfv[u] = pf.v;
        }
#pragma unroll
        for (int u = 0; u < 2; ++u) {
            const int t = tp + u;
            if (!ALL && !((act >> t) & 1u)) continue;
            o[t][0] = __builtin_amdgcn_mfma_f32_16x16x32_bf16(v.v0, pfv[u], o[t][0], 0, 0, 0); o[t][1] = __builtin_amdgcn_mfma_f32_16x16x32_bf16(v.v1, pfv[u], o[t][1], 0, 0, 0);
            o[t][2] = __builtin_amdgcn_mfma_f32_16x16x32_bf16(v.v2, pfv[u], o[t][2], 0, 0, 0); o[t][3] = __builtin_amdgcn_mfma_f32_16x16x32_bf16(v.v3, pfv[u], o[t][3], 0, 0, 0);
        }
    }
    v = load_v(rv, vb_next, vl);
}
__device__ __forceinline__ void attn_phase(const Params& p, LAS unsigned char* lds, int tid, int wid, int lane) {
    LAS float* tbl = (LAS float*)lds;
    LAS unsigned* bmx = (LAS unsigned*)(lds + 30720);
    if (tid == 0) *bmx = 0u;
    __syncthreads();
    for (int i = tid; i < 8 * 15 * 64; i += 512) tbl[i] = 0.f;
    __syncthreads();
    { float bm = 0.f, rv[8];
#pragma unroll
      for (int k = 0; k < 8; ++k) rv[k] = p.rpb[min(tid + 512 * k, 3719)];
#pragma unroll
      for (int k = 0; k < 8; ++k) { const int i = tid + 512 * k;
          if (i < 3720) { const int hd = i / 31, xx = i - hd * 31; const float v = rv[k] * LOG2E; tbl[hd * 64 + 16 + xx] = v; bm = fmaxf(bm, fabsf(v)); } }
      atomicMax((unsigned*)bmx, __float_as_uint(bm)); }
    __syncthreads();
    float kmax;
    { float g = fabsf(p.kg[lane]);
#pragma unroll
      for (int o = 1; o < 64; o <<= 1) g = fmaxf(g, __shfl_xor(g, o));
      kmax = 8.0f * g * 1.001f; }
    const float bmax = __uint_as_float(*bmx);
    const __amdgpu_buffer_rsrc_t rk = __builtin_amdgcn_make_buffer_rsrc((void*)p.Kn, 0, MROWS * 512 * 2, 0x00020000);
    const __amdgpu_buffer_rsrc_t rv = __builtin_amdgcn_make_buffer_rsrc((void*)p.Vt, 0, MROWS * 512 * 2, 0x00020000);
    const int fr = lane & 15, fq = lane >> 4;
    const int nper = ((int)gridDim.x + 7) >> 3;
    for (int pass = 0;; ++pass) {
        const int gi = ((int)blockIdx.x >> 3) * 2 + (wid >> 2) + pass * nper * 2;
        const int pi = gi >> 4;
        const int bh = pi * 8 + ((int)blockIdx.x & 7);
        if (bh >= 64) break;
        const int j = wid & 3, R = gi & 15, h = bh & 7, b = bh >> 3;
        const int cs = (j == 0) ? 0 : (j == 1) ? 8 : (j == 2) ? 24 : 32;
        const int c = 16 * j + fr, c0 = min(max(c - 8, 0), 48);
        const size_t rowbase = (size_t)b * LTOT;
        const int kr_lo = min(max(4 * R - 4, 0), 56), kr_hi = min(max(4 * R - 1, 0), 56) + 8, nwin = kr_hi - kr_lo, nblk = nwin + 8;
        LAS unsigned char* qw = lds + 32768 + wid * 8192 + lane * 16;
        float m = 0.f, l[4];
#pragma unroll
        for (int t = 0; t < 4; ++t) { const bf16_t* qp = p.Q + (rowbase + (4 * R + t) * 64 + c) * 512 + h * 64 + fq * 8;
            const u32x4 qa = *(const u32x4*)qp, qb = *(const u32x4*)(qp + 32);
            *(LAS u32x4*)(qw + t * 2048) = qa; *(LAS u32x4*)(qw + t * 2048 + 1024) = qb;
            float ss = 0.f;
#pragma unroll
            for (int e = 0; e < 4; ++e) { const float a0 = bf_lo(qa[e]), a1 = bf_hi(qa[e]), b0 = bf_lo(qb[e]), b1 = bf_hi(qb[e]); ss += (a0 * a0 + a1 * a1) + (b0 * b0 + b1 * b1); }
            ss = red_sum_fq(ss);
            m = fmaxf(m, sqrtf(ss) * kmax + bmax); l[t] = 0.f; }
        f32x4 o[4][4];
#pragma unroll
        for (int t = 0; t < 4; ++t)
#pragma unroll
            for (int d = 0; d < 4; ++d) o[t][d] = (f32x4){0.f, 0.f, 0.f, 0.f};
        const int kbase = __builtin_amdgcn_readfirstlane((int)((rowbase * 512 + h * 64) * 2));
        const int vbase = __builtin_amdgcn_readfirstlane((int)(((size_t)(b * 8 + h) * 64 * LTOT) * 2));
        const unsigned kl = (unsigned)(((8 * (fr >> 2) + (fr & 3)) * 512 + fq * 8) * 2), vl = (unsigned)((fr * LTOT + fq * 8) * 2);
        const int lo = c0 - (cs + 8 * fq);
        const int dcb = cs + 8 * fq - c + 15 + 16;
        const LAS float* tbh = tbl + h * 960 + dcb;
#define ATT_TOK(i_) __builtin_amdgcn_readfirstlane((min((i_), nblk - 1) < nwin) ? (kr_lo + min((i_), nblk - 1)) * 64 + cs : 4096 + (min((i_), nblk - 1) - nwin) * 32)
#define ATT_STEP(ib_, K_, V_) do { \
            unsigned qad = (unsigned)(size_t)qw; asm volatile("" : "+v"(qad)); const LAS unsigned char* q = (const LAS unsigned char*)(size_t)qad; \
            const int tn_ = ATT_TOK((ib_) + 2); const int kbn_ = kbase + tn_ * 1024; const int vbn_ = vbase + tn_ * 2; \
            if ((ib_) >= nwin) attn_step<true, true>(K_, V_, rk, rv, kbn_, vbn_, kl, vl, q, o, m, l, 15u, tbh, lo); \
            else { const int kr = kr_lo + (ib_); unsigned act = 0; \
                _Pragma("unroll") for (int t = 0; t < 4; ++t) { const int r0 = min(max(4 * R + t - 4, 0), 56); act |= (kr >= r0 && kr < r0 + 8) ? (1u << t) : 0u; } \
                const LAS float* tb0 = tbh + (kr - 4 * R + 7) * 64; \
                if (act == 15u) attn_step<false, true>(K_, V_, rk, rv, kbn_, vbn_, kl, vl, q, o, m, l, 15u, tb0, lo); \
                else attn_step<false, false>(K_, V_, rk, rv, kbn_, vbn_, kl, vl, q, o, m, l, act, tb0, lo); } } while (0)
        KF kA, kB; VF vA, vB;
        { const int t0 = ATT_TOK(0), t1 = ATT_TOK(1);
          kA = load_k(rk, kbase + t0 * 1024, kl); vA = load_v(rv, vbase + t0 * 2, vl); kB = load_k(rk, kbase + t1 * 1024, kl); vB = load_v(rv, vbase + t1 * 2, vl); }
        for (int ib = 0; ib < nblk; ib += 2) {
            ATT_STEP(ib, kA, vA);
            if (ib + 1 < nblk) ATT_STEP(ib + 1, kB, vB);
        }
#undef ATT_STEP
#undef ATT_TOK
        int ln2 = lane; asm volatile("" : "+v"(ln2));
        const int fr2 = ln2 & 15, fq2 = ln2 >> 4, c2 = 16 * j + fr2;
        u32x2 gg[4][4];
#pragma unroll
        for (int t = 0; t < 4; ++t) {
            const bf16_t* bgp = p.BG + (rowbase + (4 * R + t) * 64 + c2) * 512 + h * 64 + 4 * fq2;
#pragma unroll
            for (int d = 0; d < 4; ++d) gg[t][d] = *(const u32x2*)(bgp + 16 * d);
        }
#pragma unroll
        for (int t = 0; t < 4; ++t) {
            const float inv = 1.0f / red_sum_fq(l[t]);
            bf16_t* op = p.MIX + ((size_t)b * 4096 + (4 * R + t) * 64 + c2) * 1024 + 512 + h * 64 + 4 * fq2;
#pragma unroll
            for (int d = 0; d < 4; ++d) {
                u32x2 w; w.x = cvt_pk_bf16(o[t][d][0] * inv * bf_lo(gg[t][d].x), o[t][d][1] * inv * bf_hi(gg[t][d].x)); w.y = cvt_pk_bf16(o[t][d][2] * inv * bf_lo(gg[t][d].y), o[t][d][3] * inv * bf_hi(gg[t][d].y));
                *(u32x2*)(op + 16 * d) = w;
            }
        }
    }
}

__device__ __forceinline__ void run_phase(const Params& p, int ph, LAS unsigned char* lds) {
    int tid_ = threadIdx.x; asm volatile("" : "+v"(tid_));
    const int tid = tid_, wid = __builtin_amdgcn_readfirstlane(tid >> 6), lane = tid & 63;
    if (ph == 0) phase0(p, lds, tid);
    else if (ph == 1) phase1(p, lds, tid, wid, lane);
    else if (ph == 2) {
        pg8::Gemm g{p.H, p.WinT, MROWS, 3584, 1024};
        Sched1 S{(int)gridDim.x, (int)blockIdx.x};
        Epi1 E{p.U, p.Vg, p.G, p.Q, p.Kn, p.BG, p.Vt, p.qg, p.kg};
        pg8::gemm_phase<Epi1, Sched1>(lds, g, S, E);
    } else if (ph == 3) {
        sgu_phase(p, lds, tid, wid, lane);
        attn_phase(p, lds, tid, wid, lane);
    } else {
        pg8::Gemm g{p.MIX, p.WoutT, 32768, 1024, 1024};
        pg8::StaticOrder S; S.init(32768, 1024, (int)gridDim.x, (int)blockIdx.x);
        EpiOut E{p.x, p.gatef, p.out};
        pg8::gemm_phase<EpiOut, pg8::StaticOrder>(lds, g, S, E);
    }
}

#if ONE_LAUNCH
__global__ __launch_bounds__(512, 2) void k_mega(Params p) {
    extern __shared__ __attribute__((aligned(16))) unsigned char shm[];
    LAS unsigned char* lds = (LAS unsigned char*)shm;
    volatile LAS unsigned* st = (volatile LAS unsigned*)(lds + 131072);
    if (threadIdx.x == 0) { st[0] = 0u; st[1] = 0u; st[2] = 0u; st[3] = 0u; }
    __syncthreads();
    const XcdBarrier xb = xcd_barrier_post(p.bar, st);
    if (p.out == nullptr) cg::this_grid().sync();
    run_phase(p, 0, lds); xcd_barrier(xb);
    run_phase(p, 1, lds); xcd_barrier(xb);
    run_phase(p, 2, lds); xcd_barrier(xb);
    run_phase(p, 3, lds); xcd_barrier(xb);
#if PROBE_PH == 31
    attn_phase(p, lds, threadIdx.x, __builtin_amdgcn_readfirstlane(threadIdx.x >> 6), threadIdx.x & 63); xcd_barrier(xb);
#elif PROBE_PH == 30
    sgu_phase(p, lds, threadIdx.x, __builtin_amdgcn_readfirstlane(threadIdx.x >> 6), threadIdx.x & 63); xcd_barrier(xb);
#elif PROBE_PH >= 0 && PROBE_PH <= 2
    run_phase(p, PROBE_PH, lds); xcd_barrier(xb);
#elif PROBE_PH == 50
    xcd_barrier(xb); xcd_barrier(xb); xcd_barrier(xb); xcd_barrier(xb);
#endif
    run_phase(p, 4, lds);
#if PROBE_PH == 4
    xcd_barrier(xb); run_phase(p, 4, lds);
#endif
}
#else
template <int PH> __global__ __launch_bounds__(512, 2) void k_phase(Params p) {
    extern __shared__ __attribute__((aligned(16))) unsigned char shm[];
    run_phase(p, PH, (LAS unsigned char*)shm);
}
#endif

extern "C" void kernel_launch(void* const* d_in, const int* in_sizes, int n_in, void* d_out, int out_size, void* d_ws, size_t ws_size, hipStream_t stream) {
    Params p{};
    p.x = (const float*)d_in[0]; p.c = (const float*)d_in[1]; p.ctx = (const float*)d_in[2]; p.c_ctx = (const float*)d_in[3];
    p.w_ada = (const float*)d_in[4]; p.b_ada = (const float*)d_in[5]; p.norm_g = (const float*)d_in[6]; p.w_in = (const float*)d_in[7];
    p.sgu_g = (const float*)d_in[8]; p.w_sp = (const float*)d_in[9]; p.b_sp = (const float*)d_in[10]; p.qg = (const float*)d_in[11];
    p.kg = (const float*)d_in[12]; p.rpb = (const float*)d_in[13]; p.w_out = (const float*)d_in[14];
    p.out = (float*)d_out;
    unsigned char* w = (unsigned char*)d_ws; size_t off = 0;
    auto take = [&](size_t bytes) { unsigned char* r = w + off; off += (bytes + 255) & ~(size_t)255; return r; };
    p.modp = (float*)take((size_t)32 * 9 * 3072 * 4);
    p.gatef = (float*)take((size_t)8 * 1024 * 4);
    p.H = (bf16_t*)take((size_t)MROWS * 1024 * 2);
    p.WinT = (bf16_t*)take((size_t)3584 * 1024 * 2);
    p.WoutT = (bf16_t*)take((size_t)1024 * 1024 * 2);
    p.Wsp = (bf16_t*)take((size_t)4 * 128 * 128 * 2);
    p.U = (bf16_t*)take((size_t)MROWS * 512 * 2); p.Vg = (bf16_t*)take((size_t)MROWS * 512 * 2); p.G = (bf16_t*)take((size_t)MROWS * 512 * 2);
    p.Q = (bf16_t*)take((size_t)MROWS * 512 * 2); p.Kn = (bf16_t*)take((size_t)MROWS * 512 * 2); p.BG = (bf16_t*)take((size_t)MROWS * 512 * 2);
    p.Vt = (bf16_t*)take((size_t)8 * 8 * 64 * LTOT * 2);
    p.MIX = (bf16_t*)take((size_t)32768 * 1024 * 2);
    p.bar = (unsigned*)take((size_t)(XCD_BAR_WORDS + 512) * 4);
    if (off > ws_size) { fprintf(stderr, "kernel_launch: workspace too small (%zu needed, %zu given)\n", off, ws_size); return; }
#if ONE_LAUNCH
    static int grid = 0;
    if (grid == 0) {
        int dev = 0, cus = 0, per_cu = 0;
        hipGetDevice(&dev); hipDeviceGetAttribute(&cus, hipDeviceAttributeMultiprocessorCount, dev);
        hipFuncSetAttribute((const void*)k_mega, hipFuncAttributeMaxDynamicSharedMemorySize, LDS_BYTES);
        hipOccupancyMaxActiveBlocksPerMultiprocessor(&per_cu, (const void*)k_mega, 512, LDS_BYTES);
        if (per_cu < 1) { fprintf(stderr, "kernel_launch: occupancy query says %d blocks per CU\n", per_cu); per_cu = 1; }
        if (per_cu > 1) per_cu = 1;
        grid = cus * per_cu;
    }
    (void)hipMemsetAsync(p.bar, 0, (size_t)(XCD_BAR_WORDS + 512) * 4, stream);
    void* args[] = {&p};
    hipError_t e = hipLaunchCooperativeKernel((const void*)k_mega, dim3(grid), dim3(512), args, LDS_BYTES, stream);
    if (e != hipSuccess) fprintf(stderr, "cooperative launch failed: %s (grid %d)\n", hipGetErrorString(e), grid);
#else
    static int inited = 0;
    if (!inited) {
        hipFuncSetAttribute((const void*)k_phase<0>, hipFuncAttributeMaxDynamicSharedMemorySize, LDS_BYTES);
        hipFuncSetAttribute((const void*)k_phase<1>, hipFuncAttributeMaxDynamicSharedMemorySize, LDS_BYTES);
        hipFuncSetAttribute((const void*)k_phase<2>, hipFuncAttributeMaxDynamicSharedMemorySize, LDS_BYTES);
        hipFuncSetAttribute((const void*)k_phase<3>, hipFuncAttributeMaxDynamicSharedMemorySize, LDS_BYTES);
        hipFuncSetAttribute((const void*)k_phase<4>, hipFuncAttributeMaxDynamicSharedMemorySize, LDS_BYTES);
        inited = 1;
    }
    const int grid = 256;
    hipLaunchKernelGGL(k_phase<0>, dim3(grid), dim3(512), LDS_BYTES, stream, p);
    hipLaunchKernelGGL(k_phase<1>, dim3(grid), dim3(512), LDS_BYTES, stream, p);
    hipLaunchKernelGGL(k_phase<2>, dim3(grid), dim3(512), LDS_BYTES, stream, p);
    hipLaunchKernelGGL(k_phase<3>, dim3(grid), dim3(512), LDS_BYTES, stream, p);
    hipLaunchKernelGGL(k_phase<4>, dim3(grid), dim3(512), LDS_BYTES, stream, p);
#endif
}
```

```cpp
#include <hip/hip_runtime.h>
#include <hip/hip_cooperative_groups.h>
#include <cstdio>
namespace cg = cooperative_groups;

#ifndef ONE_LAUNCH
#define ONE_LAUNCH 1
#endif
#ifndef PROBE_PH
#define PROBE_PH -1
#endif

#define LAS __attribute__((address_space(3)))
typedef unsigned short bf16_t;
typedef short bf16x8 __attribute__((ext_vector_type(8)));
typedef short s16x4 __attribute__((ext_vector_type(4)));
typedef float f32x4 __attribute__((ext_vector_type(4)));
typedef float f32x2 __attribute__((ext_vector_type(2)));
typedef unsigned u32x4 __attribute__((ext_vector_type(4)));
typedef unsigned u32x2 __attribute__((ext_vector_type(2)));

constexpr int LTOT = 4352;
constexpr int MROWS = 8 * LTOT;
constexpr float LOG2E = 1.4426950408889634f;
constexpr float EPS = 1e-6f;
constexpr int LDS_BYTES = 131072 + 16;

struct Params {
    const float *x, *c, *ctx, *c_ctx, *w_ada, *b_ada, *norm_g, *w_in, *sgu_g, *w_sp, *b_sp, *qg, *kg, *rpb, *w_out;
    float* out;
    float* modp;
    float* gatef;
    bf16_t* H;
    bf16_t* WinT;
    bf16_t* WoutT;
    bf16_t* Wsp;
    bf16_t *U, *Vg, *G, *Q, *Kn, *BG;
    bf16_t* Vt;
    bf16_t* MIX;
    unsigned* bar;
};

__device__ __forceinline__ unsigned cvt_pk_bf16(float lo, float hi) { unsigned r; asm volatile("v_cvt_pk_bf16_f32 %0, %1, %2" : "=v"(r) : "v"(lo), "v"(hi)); return r; }
__device__ __forceinline__ float bf_lo(unsigned w) { return __uint_as_float(w << 16); }
__device__ __forceinline__ float bf_hi(unsigned w) { return __uint_as_float(w & 0xffff0000u); }
__device__ __forceinline__ float silu_f(float v) { return v * __builtin_amdgcn_rcpf(1.0f + __expf(-v)); }
__device__ __forceinline__ float red_max_fq(float x) {
    const unsigned u = __float_as_uint(x); const auto a = __builtin_amdgcn_permlane16_swap(u, u, false, false);
    const float y = fmaxf(__uint_as_float(a[0]), __uint_as_float(a[1]));
    const unsigned v = __float_as_uint(y); const auto c = __builtin_amdgcn_permlane32_swap(v, v, false, false);
    return fmaxf(__uint_as_float(c[0]), __uint_as_float(c[1]));
}
__device__ __forceinline__ float red_sum_fq(float x) {
    const unsigned u = __float_as_uint(x); const auto a = __builtin_amdgcn_permlane16_swap(u, u, false, false);
    const float y = __uint_as_float(a[0]) + __uint_as_float(a[1]);
    const unsigned v = __float_as_uint(y); const auto c = __builtin_amdgcn_permlane32_swap(v, v, false, false);
    return __uint_as_float(c[0]) + __uint_as_float(c[1]);
}

namespace pg8 {
constexpr int BM = 256, BK = 64, HALF = 128, HTB = HALF * BK * 2, STAGE_BYTES = 8 * HTB, NXCD = 8, WGM = 8;
__host__ __device__ __forceinline__ int lds_byte(int r, int c) { const int st = (r >> 4) * 2 + (c >> 5), rr = r & 15, cc = c & 31, ob = rr * 64 + cc * 2; return st * 1024 + (ob ^ (((ob >> 9) & 1) << 5)); }
__host__ __device__ __forceinline__ void stage_rc(int b, int& R, int& C) { const int st = b / 1024, sb = b % 1024, swz = sb ^ (((sb >> 9) & 1) << 5); R = (st >> 1) * 16 + swz / 64; C = (st & 1) * 32 + (swz % 64) / 2; }
__host__ __device__ __forceinline__ int perm32(int rho) { const int n = rho >> 4, i = rho & 15; return 8 * (i >> 2) + 4 * n + (i & 3); }

struct Unit { int pm, pn; };
struct Gemm { const bf16_t* A; const bf16_t* Bt; int M, N, K; };

struct StaticOrder {
    int nM, nN, nwg, G, c;
    __host__ __device__ void init(int M, int N, int G_, int c_) { nM = M / BM; nN = N / BM; nwg = nM * nN; G = G_; c = c_; }
    __host__ __device__ bool next(int i, Unit& u) const {
        const long L = (long)i * G + c; if (L >= nwg) return false;
        int wgid = (int)L; { const int q = nwg / NXCD, r = nwg % NXCD, xcd = wgid % NXCD, off = wgid / NXCD; wgid = (xcd < r ? xcd * (q + 1) : r * (q + 1) + (xcd - r) * q) + off; }
        const int nig = WGM * nN, gid = wgid / nig, fm = gid * WGM, gsz = (nM - fm) < WGM ? (nM - fm) : WGM;
        u.pm = fm + ((wgid % nig) % gsz); u.pn = (wgid % nig) / gsz; return true;
    }
    __device__ __forceinline__ void a_ready(const Unit&) const {}
    __device__ __forceinline__ void done(const Unit&) const {}
};

__device__ __forceinline__ f32x2 gelu_pk(f32x2 v) {
    const f32x2 av = __builtin_elementwise_abs(v), d = av * 0.2316418882f + 1.0f;
    f32x2 t; t.x = __builtin_amdgcn_rcpf(d.x); t.y = __builtin_amdgcn_rcpf(d.y);
    f32x2 q = t * 0.5307027145f + (-0.7265760135f); q = q * t + 0.7107068705f; q = q * t + (-0.142248368f); q = q * t + 0.127414796f; q = q * t;
    const f32x2 s = (v * v) * (-0.72134752044f);
    f32x2 e; e.x = __builtin_amdgcn_exp2f(s.x); e.y = __builtin_amdgcn_exp2f(s.y);
    const f32x2 m = v * (q * e), r = v - m;
    f32x2 o; o.x = v.x < 0.f ? m.x : r.x; o.y = v.y < 0.f ? m.y : r.y; return o;
}

template <class Epi, class Sched>
__device__ __forceinline__ void gemm_phase(LAS unsigned char* lds, const Gemm g, const Sched& S, const Epi& E) {
    int tid_ = threadIdx.x; asm volatile("" : "+v"(tid_));
    const int tid = tid_, wid = __builtin_amdgcn_readfirstlane(tid >> 6), lane = tid & 63, wr = wid >> 2, wc = wid & 3, fr = lane & 15, fq = lane >> 4;
    const int K = g.K, nt = K / BK;
    unsigned voffA[2], voffB[2];
#pragma unroll
    for (int i = 0; i < 2; ++i) { int R, C; stage_rc(tid * 16 + i * 8192, R, C); const int Rb = Epi::PERM ? ((R & ~31) + perm32(R & 31)) : R;
        voffA[i] = (unsigned)(R * K + C) * 2u; voffB[i] = (unsigned)(Rb * K + C) * 2u; }
    const size_t kstep = (size_t)(BK * 2);
    const size_t hstep = (size_t)HALF * K * 2;
    const size_t tstep = 2 * hstep;
    const unsigned ldsw = (unsigned)wid * 1024u;
    const int aoff = lds_byte(wr * 64 + fr, fq * 8), boff = lds_byte(wc * 32 + fr, fq * 8);
#define PG8_SA(b, h) (((b) * 2 + (h)) * HTB)
#define PG8_SB(b, h) ((4 + (b) * 2 + (h)) * HTB)
#define PG8_STAGE(bufoff, gbase, voff) do { _Pragma("unroll") for (int _i = 0; _i < 2; ++_i) \
        __builtin_amdgcn_global_load_lds((const unsigned*)((const char*)(gbase) + (voff)[_i]), (LAS unsigned*)(lds + (bufoff) + ldsw + _i * 8192), 16, 0, 0); } while (0)
#define PG8_LDA(dst, b, h) do { _Pragma("unroll") for (int m = 0; m < 4; ++m) _Pragma("unroll") for (int k = 0; k < 2; ++k) dst[m][k] = *(const LAS bf16x8*)(lds + PG8_SA(b, h) + aoff + m * 2048 + k * 1024); } while (0)
#define PG8_LDB(dst, b, h) do { _Pragma("unroll") for (int n = 0; n < 2; ++n) _Pragma("unroll") for (int k = 0; k < 2; ++k) dst[n][k] = *(const LAS bf16x8*)(lds + PG8_SB(b, h) + boff + n * 2048 + k * 1024); } while (0)
#define PG8_MMA(ai, bj, At, Bt) do { __builtin_amdgcn_s_setprio(1); _Pragma("unroll") for (int m = 0; m < 4; ++m) _Pragma("unroll") for (int n = 0; n < 2; ++n) _Pragma("unroll") for (int k = 0; k < 2; ++k) \
        acc[ai][bj][m][n] = __builtin_amdgcn_mfma_f32_16x16x32_bf16(Bt[n][k], At[m][k], acc[ai][bj][m][n], 0, 0, 0); __builtin_amdgcn_s_setprio(0); } while (0)
#define PG8_WAIT_V(n) asm volatile("s_waitcnt vmcnt(" #n ")" ::: "memory")
#define PG8_WAIT_L(n) asm volatile("s_waitcnt lgkmcnt(" #n ")" ::: "memory")
#define PG8_BAR __builtin_amdgcn_s_barrier()
#define PG8_SCHED __builtin_amdgcn_sched_barrier(0)
    Unit cur, nxt; int ui = 0;
    if (!S.next(0, cur)) return;
    f32x4 acc[2][2][4][2];
#pragma unroll
    for (int a = 0; a < 2; ++a)
#pragma unroll
        for (int b = 0; b < 2; ++b)
#pragma unroll
            for (int m = 0; m < 4; ++m)
#pragma unroll
                for (int n = 0; n < 2; ++n) acc[a][b][m][n] = (f32x4){0.f, 0.f, 0.f, 0.f};
    bf16x8 At[4][2], B0[2][2], B1[2][2];
    const char* cA = (const char*)g.A + (size_t)cur.pm * tstep; const char* cB = (const char*)g.Bt + (size_t)cur.pn * tstep;
    S.a_ready(cur);
    PG8_STAGE(PG8_SB(0, 0), cB, voffB); PG8_STAGE(PG8_SA(0, 0), cA, voffA); PG8_STAGE(PG8_SB(0, 1), cB + hstep, voffB); PG8_STAGE(PG8_SA(0, 1), cA + hstep, voffA);
    if (wr == 1) PG8_BAR;
    PG8_WAIT_V(4); PG8_BAR;
    PG8_STAGE(PG8_SB(1, 0), cB + kstep, voffB); PG8_STAGE(PG8_SA(1, 0), cA + kstep, voffA); PG8_STAGE(PG8_SB(1, 1), cB + hstep + kstep, voffB);
    PG8_WAIT_V(6); PG8_BAR;
    for (;;) {
        const bool has_next = S.next(ui + 1, nxt);
        const char* nA = has_next ? (const char*)g.A + (size_t)nxt.pm * tstep : cA; const char* nB = has_next ? (const char*)g.Bt + (size_t)nxt.pn * tstep : cB;
        for (int t = 0; t < nt; t += 2) {
            const bool last = (t == nt - 2);
            const char* a1 = cA + (size_t)(t + 1) * kstep;
            const char* a2 = last ? nA : cA + (size_t)(t + 2) * kstep; const char* b2 = last ? nB : cB + (size_t)(t + 2) * kstep;
            const char* a3 = a2 + kstep; const char* b3 = b2 + kstep;
            if (last && has_next) S.a_ready(nxt);
            PG8_LDB(B0, 0, 0); PG8_SCHED; PG8_LDA(At, 0, 0); PG8_STAGE(PG8_SA(1, 1), a1 + hstep, voffA);
            PG8_WAIT_L(8); PG8_BAR; PG8_WAIT_L(0); PG8_MMA(0, 0, At, B0); PG8_BAR; PG8_SCHED;
            PG8_LDB(B1, 0, 1); PG8_STAGE(PG8_SB(0, 0), b2, voffB);
            PG8_BAR; PG8_WAIT_L(0); PG8_MMA(0, 1, At, B1); PG8_BAR;
            PG8_LDA(At, 0, 1); PG8_STAGE(PG8_SA(0, 0), a2, voffA);
            PG8_BAR; PG8_WAIT_L(0); PG8_MMA(1, 0, At, B0); PG8_BAR; PG8_SCHED;
            PG8_STAGE(PG8_SB(0, 1), b2 + hstep, voffB);
            PG8_WAIT_V(6); PG8_BAR; PG8_MMA(1, 1, At, B1); PG8_BAR;
            PG8_LDB(B0, 1, 0); PG8_SCHED; PG8_LDA(At, 1, 0); PG8_STAGE(PG8_SA(0, 1), a2 + hstep, voffA);
            PG8_WAIT_L(8); PG8_BAR; PG8_WAIT_L(0); PG8_MMA(0, 0, At, B0); PG8_BAR; PG8_SCHED;
            PG8_LDB(B1, 1, 1); PG8_STAGE(PG8_SB(1, 0), b3, voffB);
            PG8_BAR; PG8_WAIT_L(0); PG8_MMA(0, 1, At, B1); PG8_BAR;
            PG8_LDA(At, 1, 1); PG8_STAGE(PG8_SA(1, 0), a3, voffA);
            PG8_BAR; PG8_WAIT_L(0); PG8_MMA(1, 0, At, B0); PG8_BAR; PG8_SCHED;
            PG8_STAGE(PG8_SB(1, 1), b3 + hstep, voffB);
            PG8_WAIT_V(6); PG8_BAR; PG8_MMA(1, 1, At, B1); PG8_BAR;
        }
        E(acc, cur, wr, wc, fr, fq); S.done(cur);
        if (!has_next) break;
#pragma unroll
        for (int a = 0; a < 2; ++a)
#pragma unroll
            for (int b = 0; b < 2; ++b)
#pragma unroll
                for (int m = 0; m < 4; ++m)
#pragma unroll
                    for (int n = 0; n < 2; ++n) acc[a][b][m][n] = (f32x4){0.f, 0.f, 0.f, 0.f};
        cur = nxt; cA = nA; cB = nB; ++ui;
    }
    PG8_WAIT_V(0);
    if (wr == 0) PG8_BAR;
    PG8_BAR;
#undef PG8_SA
#undef PG8_SB
#undef PG8_STAGE
#undef PG8_LDA
#undef PG8_LDB
#undef PG8_MMA
#undef PG8_WAIT_V
#undef PG8_WAIT_L
#undef PG8_BAR
#undef PG8_SCHED
}
}

struct Sched1 {
    int G, c;
    __device__ bool next(int i, pg8::Unit& u) const {
        const int L = i * G + c; if (L >= 1792) return false;
        const int wgid = (L & 7) * 224 + (L >> 3);
        const int gid = wgid / 112, rem = wgid - gid * 112;
        const int pml = gid * 8 + (rem & 7);
        u.pm = pml + (pml >> 4); u.pn = rem >> 3;
        return true;
    }
    __device__ __forceinline__ void a_ready(const pg8::Unit&) const {}
    __device__ __forceinline__ void done(const pg8::Unit&) const {}
};

struct Epi1 {
    static constexpr bool PERM = true;
    bf16_t *U, *Vg, *G, *Q, *Kn, *BG, *Vt; const float *qg, *kg;
    __device__ __forceinline__ void operator()(const f32x4 (&acc)[2][2][4][2], const pg8::Unit& u, int wr, int wc, int fr, int fq) const {
        const int type = u.pn >> 1, half = u.pn & 1;
        const size_t row0 = (size_t)u.pm * 256 + wr * 64 + fr;
        if (type == 5) {
            const int b = u.pm / 17, t0 = (u.pm - b * 17) * 256 + wr * 64 + fr;
#pragma unroll
            for (int bj = 0; bj < 2; ++bj)
#pragma unroll
                for (int n = 0; n < 2; ++n)
#pragma unroll
                    for (int e = 0; e < 4; ++e) {
                        const int cc = half * 256 + bj * 128 + wc * 32 + 8 * fq + 4 * n + e;
                        bf16_t* base = Vt + ((size_t)b * 512 + cc) * LTOT + t0;
#pragma unroll
                        for (int ai = 0; ai < 2; ++ai)
#pragma unroll
                            for (int m = 0; m < 4; ++m) base[ai * 128 + m * 16] = (bf16_t)(cvt_pk_bf16(acc[ai][bj][m][n][e], 0.f) & 0xffffu);
                    }
        } else if (type == 3 || type == 4) {
            const float* gw = (type == 3) ? qg : kg; const float mul = (type == 3) ? 0.125f * LOG2E : 1.0f;
            bf16_t* O = (type == 3) ? Q : Kn;
            f32x4 gv[2][2];
#pragma unroll
            for (int bj = 0; bj < 2; ++bj)
#pragma unroll
                for (int n = 0; n < 2; ++n) gv[bj][n] = *(const f32x4*)(gw + bj * 32 + 8 * fq + 4 * n) * mul;
            const int colbase = half * 256 + wc * 64 + 8 * fq;
#pragma unroll
            for (int ai = 0; ai < 2; ++ai)
#pragma unroll
                for (int m = 0; m < 4; ++m) {
                    float ss = 0.f;
#pragma unroll
                    for (int bj = 0; bj < 2; ++bj)
#pragma unroll
                        for (int n = 0; n < 2; ++n) { const f32x4 v = acc[ai][bj][m][n]; ss += (v[0] * v[0] + v[1] * v[1]) + (v[2] * v[2] + v[3] * v[3]); }
                    ss = red_sum_fq(ss);
                    const float rstd = __builtin_amdgcn_rsqf(ss * (1.0f / 64.0f) + EPS);
                    bf16_t* rowp = O + (row0 + ai * 128 + m * 16) * 512 + colbase;
#pragma unroll
                    for (int bj = 0; bj < 2; ++bj) {
                        const f32x4 v0 = acc[ai][bj][m][0] * rstd * gv[bj][0], v1 = acc[ai][bj][m][1] * rstd * gv[bj][1];
                        u32x4 w; w.x = cvt_pk_bf16(v0[0], v0[1]); w.y = cvt_pk_bf16(v0[2], v0[3]); w.z = cvt_pk_bf16(v1[0], v1[1]); w.w = cvt_pk_bf16(v1[2], v1[3]);
                        *(u32x4*)(rowp + bj * 32) = w;
                    }
                }
        } else {
            bf16_t* O = (type == 0) ? U : (type == 1) ? Vg : (type == 2) ? G : BG;
            const int col0 = half * 256 + wc * 32 + 8 * fq;
            const bool is_gelu = type <= 1;
#pragma unroll
            for (int ai = 0; ai < 2; ++ai)
#pragma unroll
                for (int m = 0; m < 4; ++m) {
                    bf16_t* rowp = O + (row0 + ai * 128 + m * 16) * 512 + col0;
#pragma unroll
                    for (int bj = 0; bj < 2; ++bj) {
                        f32x4 v0 = acc[ai][bj][m][0], v1 = acc[ai][bj][m][1];
                        if (is_gelu) {
                            const f32x2 a = pg8::gelu_pk((f32x2){v0[0], v0[1]}), b = pg8::gelu_pk((f32x2){v0[2], v0[3]}), c = pg8::gelu_pk((f32x2){v1[0], v1[1]}), d = pg8::gelu_pk((f32x2){v1[2], v1[3]});
                            v0 = (f32x4){a.x, a.y, b.x, b.y}; v1 = (f32x4){c.x, c.y, d.x, d.y};
                        } else {
#pragma unroll
                            for (int j = 0; j < 4; ++j) { v0[j] = silu_f(v0[j]); v1[j] = silu_f(v1[j]); }
                        }
                        u32x4 w; w.x = cvt_pk_bf16(v0[0], v0[1]); w.y = cvt_pk_bf16(v0[2], v0[3]); w.z = cvt_pk_bf16(v1[0], v1[1]); w.w = cvt_pk_bf16(v1[2], v1[3]);
                        *(u32x4*)(rowp + bj * 128) = w;
                    }
                }
        }
    }
};

struct EpiOut {
    static constexpr bool PERM = false;
    const float* x; const float* gatef; float* out;
    __device__ __forceinline__ void operator()(const f32x4 (&acc)[2][2][4][2], const pg8::Unit& u, int wr, int wc, int fr, int fq) const {
        const size_t row0 = (size_t)u.pm * 256 + wr * 64 + fr; const int col0 = u.pn * 256 + wc * 32 + 4 * fq; const int b = u.pm >> 4;
        f32x4 gv[2][2];
#pragma unroll
        for (int bj = 0; bj < 2; ++bj)
#pragma unroll
            for (int n = 0; n < 2; ++n) gv[bj][n] = *(const f32x4*)(gatef + b * 1024 + col0 + bj * 128 + n * 16);
#pragma unroll
        for (int ai = 0; ai < 2; ++ai) {
            f32x4 xv[4][2][2];
#pragma unroll
            for (int m = 0; m < 4; ++m)
#pragma unroll
                for (int bj = 0; bj < 2; ++bj)
#pragma unroll
                    for (int n = 0; n < 2; ++n) xv[m][bj][n] = __builtin_nontemporal_load((const f32x4*)(x + (row0 + ai * 128 + m * 16) * 1024 + col0 + bj * 128 + n * 16));
#pragma unroll
            for (int m = 0; m < 4; ++m)
#pragma unroll
                for (int bj = 0; bj < 2; ++bj)
#pragma unroll
                    for (int n = 0; n < 2; ++n)
                        *(f32x4*)(out + (row0 + ai * 128 + m * 16) * 1024 + col0 + bj * 128 + n * 16) = xv[m][bj][n] + gv[bj][n] * acc[ai][bj][m][n];
        }
    }
};

__device__ __forceinline__ int win_actual_col(int n) {
    if (n < 1536 || n >= 2560) return n;
    const int g = n & 255;
    return (n & ~255) + ((g >> 5) & 3) * 64 + (g >> 7) * 32 + (g & 31);
}
struct TrItem { const float* src; bf16_t* dst; int N; };
__device__ __forceinline__ TrItem tr_item(const Params& p, int r, int tid) {
    TrItem t; const int kr = tid >> 3, ch = tid & 7;
    if (r < 896) { const int n0 = (r >> 4) * 64, k0 = (r & 15) * 64; t.N = 3584; t.src = p.w_in + (size_t)(k0 + kr) * 3584 + win_actual_col(n0 + ch * 8); t.dst = p.WinT + (size_t)n0 * 1024 + k0; }
    else { const int q = r - 896, n0 = (q >> 4) * 64, k0 = (q & 15) * 64; t.N = 1024; t.src = p.w_out + (size_t)(k0 + kr) * 1024 + n0 + ch * 8; t.dst = p.WoutT + (size_t)n0 * 1024 + k0; }
    return t;
}
struct MapCtxCols { __device__ __forceinline__ int operator()(int q) const { return 512 + q; } };
struct MapRest    { __device__ __forceinline__ int operator()(int q) const { return q < 512 ? q : q + 256; } };
struct MapAll     { __device__ __forceinline__ int operator()(int q) const { return q; } };
template <class Map>
__device__ __forceinline__ void transpose_items(const Params& p, LAS float* fl, int tid, int first, int step, int count, Map map) {
    const int kr = tid >> 3, ch = tid & 7;
    f32x4 ra0, rb0, ra1, rb1; TrItem c0{}, c1{};
    int q = first, par = 0;
    if (q < count) { c0 = tr_item(p, map(q), tid); ra0 = *(const f32x4*)c0.src; rb0 = *(const f32x4*)(c0.src + 4); }
    if (q + step < count) { c1 = tr_item(p, map(q + step), tid); ra1 = *(const f32x4*)c1.src; rb1 = *(const f32x4*)(c1.src + 4); }
    while (q < count) {
        const bool two = q + step < count;
        LAS float* tl0 = fl + 4096 + par * (2 * 64 * 65); LAS float* tl1 = tl0 + 64 * 65;
        { LAS float* d = tl0 + (ch * 8) * 65 + kr;
          d[0] = ra0[0]; d[65] = ra0[1]; d[130] = ra0[2]; d[195] = ra0[3]; d[260] = rb0[0]; d[325] = rb0[1]; d[390] = rb0[2]; d[455] = rb0[3]; }
        if (two) { LAS float* d = tl1 + (ch * 8) * 65 + kr;
          d[0] = ra1[0]; d[65] = ra1[1]; d[130] = ra1[2]; d[195] = ra1[3]; d[260] = rb1[0]; d[325] = rb1[1]; d[390] = rb1[2]; d[455] = rb1[3]; }
        __syncthreads();
        const int qn = q + 2 * step; const TrItem m0 = c0, m1 = c1;
        if (qn < count) { c0 = tr_item(p, map(qn), tid); ra0 = *(const f32x4*)c0.src; rb0 = *(const f32x4*)(c0.src + 4); }
        if (qn + step < count) { c1 = tr_item(p, map(qn + step), tid); ra1 = *(const f32x4*)c1.src; rb1 = *(const f32x4*)(c1.src + 4); }
        { const LAS float* sp = tl0 + kr * 65 + ch * 8;
          u32x4 w; w.x = cvt_pk_bf16(sp[0], sp[1]); w.y = cvt_pk_bf16(sp[2], sp[3]); w.z = cvt_pk_bf16(sp[4], sp[5]); w.w = cvt_pk_bf16(sp[6], sp[7]);
          *(u32x4*)(m0.dst + (size_t)kr * 1024 + ch * 8) = w; }
        if (two) { const LAS float* sp = tl1 + kr * 65 + ch * 8;
          u32x4 w; w.x = cvt_pk_bf16(sp[0], sp[1]); w.y = cvt_pk_bf16(sp[2], sp[3]); w.z = cvt_pk_bf16(sp[4], sp[5]); w.w = cvt_pk_bf16(sp[6], sp[7]);
          *(u32x4*)(m1.dst + (size_t)kr * 1024 + ch * 8) = w; }
        q = qn; par ^= 1;
    }
}
__device__ __forceinline__ void phase0(const Params& p, LAS unsigned char* lds, int tid) {
    LAS float* fl = (LAS float*)lds;
    for (int it = blockIdx.x; it < 192; it += gridDim.x) {
        const int cgi = it >> 4, ks = it & 15;
        __syncthreads();
        { float cvv[2];
#pragma unroll
          for (int u = 0; u < 2; ++u) { const int i = min(tid + 512 * u, 575), r = i >> 6, k = ks * 64 + (i & 63); const float* src = (r < 8) ? p.c + r * 1024 + k : p.c_ctx + k; cvv[u] = *src; }
#pragma unroll
          for (int u = 0; u < 2; ++u) { const int i = tid + 512 * u; if (i < 576) fl[(i & 63) * 12 + (i >> 6)] = cvv[u] / (1.0f + __expf(-cvv[u])); } }
        __syncthreads();
        const int col = cgi * 256 + (tid & 255), kh = tid >> 8;
        float a0 = 0.f, a1 = 0.f, a2 = 0.f, a3 = 0.f, a4 = 0.f, a5 = 0.f, a6 = 0.f, a7 = 0.f, a8 = 0.f;
        const float* wp = p.w_ada + (size_t)(ks * 64 + kh * 32) * 3072 + col;
#pragma unroll
        for (int kk = 0; kk < 32; ++kk) {
            const int kl = kh * 32 + kk; const float w = __builtin_nontemporal_load(wp + (size_t)kk * 3072);
            const LAS f32x4* f = (const LAS f32x4*)(fl + kl * 12); const f32x4 s0 = f[0], s1 = f[1]; const float s8 = fl[kl * 12 + 8];
            a0 += s0[0] * w; a1 += s0[1] * w; a2 += s0[2] * w; a3 += s0[3] * w; a4 += s1[0] * w;
            a5 += s1[1] * w; a6 += s1[2] * w; a7 += s1[3] * w; a8 += s8 * w;
        }
        LAS float* ex = fl + 1536; const int tc = tid & 255;
        if (kh == 1) { ex[tc] = a0; ex[256 + tc] = a1; ex[512 + tc] = a2; ex[768 + tc] = a3; ex[1024 + tc] = a4; ex[1280 + tc] = a5; ex[1536 + tc] = a6; ex[1792 + tc] = a7; ex[2048 + tc] = a8; }
        __syncthreads();
        if (kh == 0) { float* o = p.modp + (size_t)(ks * 9) * 3072 + col;
            o[0] = a0 + ex[tc]; o[3072] = a1 + ex[256 + tc]; o[2 * 3072] = a2 + ex[512 + tc]; o[3 * 3072] = a3 + ex[768 + tc]; o[4 * 3072] = a4 + ex[1024 + tc];
            o[5 * 3072] = a5 + ex[1280 + tc]; o[6 * 3072] = a6 + ex[1536 + tc]; o[7 * 3072] = a7 + ex[1792 + tc]; o[8 * 3072] = a8 + ex[2048 + tc]; }
    }
    __syncthreads();
    if (gridDim.x == 256) { if (blockIdx.x >= 192) transpose_items(p, fl, tid, (int)blockIdx.x - 192, 64, 256, MapCtxCols()); }
    else transpose_items(p, fl, tid, (int)blockIdx.x, (int)gridDim.x, 1152, MapAll());
    for (int i = blockIdx.x * 512 + tid; i < 32768; i += gridDim.x * 512) { const float a = p.w_sp[2 * i], b = p.w_sp[2 * i + 1]; ((unsigned*)p.Wsp)[i] = cvt_pk_bf16(a, b); }
}

#define XB_TMO      128
#define XB_XCNT(j)  (256  + 64 * (j))
#define XB_XSUB(j)  (1280 + 64 * (j))
#define XB_XGEN(j)  (2304 + 64 * (j))
#define XB_TOP      3328
#define XB_TOPGEN   3392
#define XCD_BAR_WORDS 3456
#define XB_SPIN_CAP (1u << 18)
__device__ __forceinline__ unsigned xb_ld(unsigned* p)              { return __hip_atomic_load(p, __ATOMIC_RELAXED, __HIP_MEMORY_SCOPE_AGENT); }
__device__ __forceinline__ unsigned xb_add(unsigned* p, unsigned v) { return __hip_atomic_fetch_add(p, v, __ATOMIC_RELAXED, __HIP_MEMORY_SCOPE_AGENT); }
__device__ __forceinline__ unsigned xb_xcc_id() { return (unsigned)__builtin_amdgcn_s_getreg((3 << 11) | 20) & 0xFu; }
#define XB_SPIN(cond, bar) do { unsigned _sp = 0; while (cond) { __builtin_amdgcn_s_sleep(1); \
    if ((++_sp & 255u) == 0u) { if (xb_ld(&(bar)[XB_TMO])) break; if (_sp > XB_SPIN_CAP) { atomicAdd(&(bar)[XB_TMO], 1u); break; } } } } while (0)
struct XcdBarrier { unsigned* bar; unsigned x; volatile LAS unsigned* st; };
__device__ __forceinline__ XcdBarrier xcd_barrier_post(unsigned* bar, volatile LAS unsigned* st) {
    XcdBarrier b; b.bar = bar; b.x = xb_xcc_id(); b.st = st;
    if (threadIdx.x == 0) (void)xb_add(&bar[XB_XCNT(b.x)], 1u);
    return b;
}
__device__ __forceinline__ void xcd_barrier_complete(unsigned* bar, unsigned x, unsigned& nloc, unsigned& nx) {
    const unsigned G = gridDim.x * gridDim.y * gridDim.z;
    unsigned sum, cnt, mine, sp = 0u;
    for (;;) {
        sum = 0u; cnt = 0u; mine = 0u;
#pragma unroll
        for (unsigned j = 0; j < 16; ++j) { const unsigned c = xb_ld(&bar[XB_XCNT(j)]); sum += c; cnt += (c > 0u) ? 1u : 0u; mine = (j == x) ? c : mine; }
        if (sum == G) break;
        __builtin_amdgcn_s_sleep(1);
        if ((++sp & 255u) == 0u) { if (xb_ld(&bar[XB_TMO])) break; if (sp > XB_SPIN_CAP) { atomicAdd(&bar[XB_TMO], 1u); break; } }
    }
    nloc = mine > 0u ? mine : 1u; nx = cnt > 0u ? cnt : 1u;
}
__device__ __forceinline__ void xcd_barrier(const XcdBarrier& b) {
    asm volatile("s_waitcnt vmcnt(0)" ::: "memory");
    __syncthreads();
    if (threadIdx.x == 0) {
        unsigned* bar = b.bar;
        __builtin_amdgcn_s_waitcnt(0);
        unsigned nloc = b.st[0], nx = b.st[1];
        if (nloc == 0u) { xcd_barrier_complete(bar, b.x, nloc, nx); b.st[0] = nloc; b.st[1] = nx; }
        const unsigned old = xb_add(&bar[XB_XSUB(b.x)], 1u);
        const unsigned gen = old / nloc;
        if (old + 1u == (gen + 1u) * nloc) {
            __builtin_amdgcn_fence(__ATOMIC_RELEASE, "agent");
            asm volatile("s_waitcnt vmcnt(0)" ::: "memory");
            const unsigned og = xb_add(&bar[XB_TOP], 1u);
            const unsigned tg = og / nx;
            if (og + 1u == (tg + 1u) * nx) xb_add(&bar[XB_TOPGEN], 1u);
            else XB_SPIN(xb_ld(&bar[XB_TOPGEN]) == tg, bar);
            __builtin_amdgcn_fence(__ATOMIC_ACQUIRE, "agent");
            xb_add(&bar[XB_XGEN(b.x)], 1u);
            asm volatile("s_waitcnt vmcnt(0)" ::: "memory");
        } else {
            XB_SPIN(xb_ld(&bar[XB_XGEN(b.x)]) == gen, bar);
            __builtin_amdgcn_fence(__ATOMIC_ACQUIRE, "agent");
            asm volatile("s_waitcnt vmcnt(0)" ::: "memory");
        }
    }
    __syncthreads();
}


struct SchedOne {
    int pm, pn;
    __device__ bool next(int i, pg8::Unit& u) const { if (i > 0) return false; u.pm = pm; u.pn = pn; return true; }
    __device__ __forceinline__ void a_ready(const pg8::Unit&) const {}
    __device__ __forceinline__ void done(const pg8::Unit&) const {}
};
__device__ __forceinline__ void rows4_load(f32x4 (&v)[4][4], const float* src0, int lane) {
#pragma unroll
    for (int rr = 0; rr < 4; ++rr)
#pragma unroll
        for (int j = 0; j < 4; ++j) v[rr][j] = __builtin_nontemporal_load((const f32x4*)(src0 + (size_t)rr * 1024 + j * 256 + lane * 4));
}
template <bool WT>
__device__ __forceinline__ void rows4_store(const f32x4 (&v)[4][4], bf16_t* dst0, const LAS float* sc_, const LAS float* sh_, int lane) {
#pragma unroll
    for (int rr = 0; rr < 4; ++rr) {
        float ss = 0.f;
#pragma unroll
        for (int j = 0; j < 4; ++j) ss += (v[rr][j][0] * v[rr][j][0] + v[rr][j][1] * v[rr][j][1]) + (v[rr][j][2] * v[rr][j][2] + v[rr][j][3] * v[rr][j][3]);
#pragma unroll
        for (int o = 1; o < 64; o <<= 1) ss += __shfl_xor(ss, o);
        const float rstd = __builtin_amdgcn_rsqf(ss * (1.0f / 1024.0f) + EPS);
        bf16_t* drp = dst0 + (size_t)rr * 1024;
#pragma unroll
        for (int j = 0; j < 4; ++j) {
            const int k = j * 256 + lane * 4;
            const f32x4 a = *(const LAS f32x4*)(sc_ + k), sv = *(const LAS f32x4*)(sh_ + k);
            const f32x4 hv = v[rr][j] * rstd * a + sv;
            u32x2 w; w.x = cvt_pk_bf16(hv[0], hv[1]); w.y = cvt_pk_bf16(hv[2], hv[3]);
            if (WT) __hip_atomic_store((unsigned long long*)(drp + k), (unsigned long long)w.x | ((unsigned long long)w.y << 32), __ATOMIC_RELAXED, __HIP_MEMORY_SCOPE_AGENT);
            else *(u32x2*)(drp + k) = w;
        }
    }
}
template <bool WT>
__device__ __forceinline__ void norm_rows4(const float* src0, bf16_t* dst0, const LAS float* sc_, const LAS float* sh_, int lane) {
    f32x4 v[4][4]; rows4_load(v, src0, lane); rows4_store<WT>(v, dst0, sc_, sh_, lane);
}
__device__ __forceinline__ void mod_tables(const Params& p, int row, LAS float* T, int tid, float* gate_out) {
    for (int k = tid; k < 1024; k += 512) {
        float s_sh = p.b_ada[k], s_sc = p.b_ada[1024 + k], s_g = p.b_ada[2048 + k];
#pragma unroll
        for (int ks = 0; ks < 16; ++ks) { const float* mb = p.modp + (size_t)(ks * 9 + row) * 3072 + k; s_sh += mb[0]; s_sc += mb[1024]; s_g += mb[2048]; }
        T[k] = p.norm_g[k] * (1.0f + s_sc); T[1024 + k] = s_sh;
        if (gate_out) gate_out[k] = s_g;
    }
}
__device__ __forceinline__ void phase1(const Params& p, LAS unsigned char* lds, int tid, int wid, int lane) {
    LAS float* T = (LAS float*)lds;
    if (blockIdx.x < 32) {
        const int i = blockIdx.x, cb = i >> 2;
        const int r0 = (i & 3) * 64 + wid * 8;
        f32x4 va[4][4], vb[4][4];
        rows4_load(va, p.ctx + ((size_t)cb * 256 + r0) * 1024, lane); rows4_load(vb, p.ctx + ((size_t)cb * 256 + r0 + 4) * 1024, lane);
        mod_tables(p, 8, T, tid, nullptr);
        __syncthreads();
        rows4_store<true>(va, p.H + ((size_t)cb * LTOT + 4096 + r0) * 1024, T, T + 1024, lane);
        rows4_store<true>(vb, p.H + ((size_t)cb * LTOT + 4096 + r0 + 4) * 1024, T, T + 1024, lane);
        asm volatile("s_waitcnt vmcnt(0)" ::: "memory"); __syncthreads();
        if (tid == 0) {
            unsigned* cw = p.bar + XCD_BAR_WORDS + 64 * cb;
            (void)xb_add(cw, 1u);
            XB_SPIN(xb_ld(cw) < 4u, p.bar);
            __builtin_amdgcn_fence(__ATOMIC_ACQUIRE, "agent"); asm volatile("s_waitcnt vmcnt(0)" ::: "memory");
        }
        __syncthreads();
        pg8::Gemm g{p.H, p.WinT, MROWS, 3584, 1024};
        SchedOne S{cb * 17 + 16, 8 + (i & 3)};
        Epi1 E{p.U, p.Vg, p.G, p.Q, p.Kn, p.BG, p.Vt, p.qg, p.kg};
        pg8::gemm_phase<Epi1, SchedOne>(lds, g, S, E);
    } else {
        const int nb = (int)gridDim.x - 32, j = (int)blockIdx.x - 32;
        const int q0 = (int)(((long)j * 8192) / nb), q1 = (int)(((long)(j + 1) * 8192) / nb);
        const int b0 = q0 >> 10, b1 = (q1 - 1) >> 10;
        mod_tables(p, b0, T, tid, p.gatef + b0 * 1024);
        if (b1 != b0) mod_tables(p, b1, T + 2048, tid, p.gatef + b1 * 1024);
        __syncthreads();
        for (int q = q0 + wid; q < q1; q += 8) {
            const int bb = q >> 10; const LAS float* tab = (bb == b0) ? T : T + 2048;
            norm_rows4<false>(p.x + (size_t)q * 4096, p.H + ((size_t)bb * LTOT + (q & 1023) * 4) * 1024, tab, tab + 1024, lane);
        }
        if (gridDim.x == 256) transpose_items(p, T, tid, j, nb, 896, MapRest());
    }
}

__device__ __forceinline__ void sgu_phase(const Params& p, LAS unsigned char* lds, int tid, int wid, int lane) {
    constexpr int RS = 272;
    LAS float* gL = (LAS float*)lds;
    LAS float* bL = gL + 512;
    LAS unsigned char* wsL = lds + 32768; LAS unsigned char* vL = wsL + 128 * RS;
    const int fr = lane & 15, fq = lane >> 4;
    const int q = tid >> 2, qt = tid & 3;
    gL[tid] = p.sgu_g[tid]; bL[tid] = p.b_sp[tid];
    for (int unit = blockIdx.x; unit < 256; unit += gridDim.x) {
        const int b = unit >> 5, n = unit & 31;
        const size_t rowbase = (size_t)b * LTOT + n * 128, mixrow = (size_t)b * 4096 + n * 128;
        const size_t grow = rowbase + 16 * wid + fr;
        u32x4 wreg[4], vraw[4]; u32x4 uu[4], gg[4];
#pragma unroll
        for (int i = 0; i < 4; ++i) { const int idx = tid + 512 * i; wreg[i] = *(const u32x4*)(p.Wsp + (size_t)(idx >> 4) * 128 + (idx & 15) * 8);
            vraw[i] = *(const u32x4*)(p.Vg + (rowbase + q) * 512 + 32 * qt + 8 * i); }
#pragma unroll
        for (int k2 = 0; k2 < 4; ++k2) { const int colc = 32 * k2 + 8 * fq; uu[k2] = *(const u32x4*)(p.U + grow * 512 + colc); gg[k2] = *(const u32x4*)(p.G + grow * 512 + colc); }
#pragma unroll
        for (int g = 0; g < 4; ++g) {
            __syncthreads();
#pragma unroll
            for (int i = 0; i < 4; ++i) { const int idx = tid + 512 * i; *(LAS u32x4*)(wsL + (idx >> 4) * RS + (idx & 15) * 16) = wreg[i]; }
            { float ss = 0.f;
#pragma unroll
              for (int i = 0; i < 4; ++i)
#pragma unroll
                  for (int j = 0; j < 4; ++j) { const float a = bf_lo(vraw[i][j]), bb = bf_hi(vraw[i][j]); ss += a * a + bb * bb; }
              ss += __shfl_xor(ss, 1); ss += __shfl_xor(ss, 2);
              const float rstd = __builtin_amdgcn_rsqf(ss * (1.0f / 128.0f) + EPS);
              const LAS float* gp = gL + g * 128 + 32 * qt;
#pragma unroll
              for (int i = 0; i < 4; ++i) { u32x4 w; const f32x4 g0 = *(const LAS f32x4*)(gp + 8 * i), g1 = *(const LAS f32x4*)(gp + 8 * i + 4);
                  w[0] = cvt_pk_bf16(bf_lo(vraw[i][0]) * rstd * g0[0], bf_hi(vraw[i][0]) * rstd * g0[1]); w[1] = cvt_pk_bf16(bf_lo(vraw[i][1]) * rstd * g0[2], bf_hi(vraw[i][1]) * rstd * g0[3]);
                  w[2] = cvt_pk_bf16(bf_lo(vraw[i][2]) * rstd * g1[0], bf_hi(vraw[i][2]) * rstd * g1[1]); w[3] = cvt_pk_bf16(bf_lo(vraw[i][3]) * rstd * g1[2], bf_hi(vraw[i][3]) * rstd * g1[3]);
                  *(LAS u32x4*)(vL + q * RS + 64 * qt + 16 * i) = w; } }
            __syncthreads();
            u32x4 uun[4], ggn[4];
            if (g < 3) {
#pragma unroll
                for (int i = 0; i < 4; ++i) { const int idx = tid + 512 * i; wreg[i] = *(const u32x4*)(p.Wsp + (size_t)((g + 1) * 128 + (idx >> 4)) * 128 + (idx & 15) * 8);
                    vraw[i] = *(const u32x4*)(p.Vg + (rowbase + q) * 512 + (g + 1) * 128 + 32 * qt + 8 * i); }
#pragma unroll
                for (int k2 = 0; k2 < 4; ++k2) { const int colc = (g + 1) * 128 + 32 * k2 + 8 * fq; uun[k2] = *(const u32x4*)(p.U + grow * 512 + colc); ggn[k2] = *(const u32x4*)(p.G + grow * 512 + colc); }
            }
            bf16x8 wf[4];
#pragma unroll
            for (int ks = 0; ks < 4; ++ks) wf[ks] = *(const LAS bf16x8*)(wsL + (16 * wid + fr) * RS + ks * 64 + fq * 16);
            const float bias = bL[g * 128 + 16 * wid + fr];
            const int traddr = (8 * fq + ((lane & 15) >> 2)) * RS + 16 * (lane & 3);
            u32x4 wout[4];
#pragma unroll
            for (int cb = 0; cb < 8; ++cb) {
                f32x4 acc = {0.f, 0.f, 0.f, 0.f};
#pragma unroll
                for (int ks = 0; ks < 4; ++ks) {
                    const s16x4 a0 = __builtin_amdgcn_ds_read_tr16_b64_v4i16((LAS s16x4*)(vL + traddr + (32 * ks) * RS + 64 * (cb >> 1) + 8 * (cb & 1)));
                    const s16x4 a1 = __builtin_amdgcn_ds_read_tr16_b64_v4i16((LAS s16x4*)(vL + traddr + (32 * ks + 4) * RS + 64 * (cb >> 1) + 8 * (cb & 1)));
                    const bf16x8 a = {a0[0], a0[1], a0[2], a0[3], a1[0], a1[1], a1[2], a1[3]};
                    acc = __builtin_amdgcn_mfma_f32_16x16x32_bf16(a, wf[ks], acc, 0, 0, 0);
                }
                const unsigned ua = uu[cb >> 1][2 * (cb & 1)], ub = uu[cb >> 1][2 * (cb & 1) + 1], ga = gg[cb >> 1][2 * (cb & 1)], gb = gg[cb >> 1][2 * (cb & 1) + 1];
                const float o0 = bf_lo(ua) * (acc[0] + bias) * bf_lo(ga), o1 = bf_hi(ua) * (acc[1] + bias) * bf_hi(ga);
                const float o2 = bf_lo(ub) * (acc[2] + bias) * bf_lo(gb), o3 = bf_hi(ub) * (acc[3] + bias) * bf_hi(gb);
                wout[cb >> 1][2 * (cb & 1)] = cvt_pk_bf16(o0, o1); wout[cb >> 1][2 * (cb & 1) + 1] = cvt_pk_bf16(o2, o3);
            }
#pragma unroll
            for (int k2 = 0; k2 < 4; ++k2) *(u32x4*)(p.MIX + (mixrow + 16 * wid + fr) * 1024 + g * 128 + 32 * k2 + 8 * fq) = wout[k2];
            if (g < 3) {
#pragma unroll
                for (int k2 = 0; k2 < 4; ++k2) { uu[k2] = uun[k2]; gg[k2] = ggn[k2]; }
            }
        }
    }
    __syncthreads();
}

struct KF { bf16x8 k00, k01, k10, k11; };
struct VF { bf16x8 v0, v1, v2, v3; };
__device__ __forceinline__ bf16x8 buf16(__amdgpu_buffer_rsrc_t r, unsigned voff, int soff) { union { u32x4 u; bf16x8 v; } x; x.u = __builtin_amdgcn_raw_buffer_load_b128(r, (int)voff, soff, 0); return x.v; }
__device__ __forceinline__ KF load_k(__amdgpu_buffer_rsrc_t rk, int so, unsigned kl) {
    KF r; r.k00 = buf16(rk, kl, so); r.k01 = buf16(rk, kl + 64u, so); r.k10 = buf16(rk, kl, so + 4096); r.k11 = buf16(rk, kl + 64u, so + 4096);
    return r;
}
__device__ __forceinline__ VF load_v(__amdgpu_buffer_rsrc_t rv, int so, unsigned vl) {
    VF r; r.v0 = buf16(rv, vl, so); r.v1 = buf16(rv, vl, so + 16 * LTOT * 2); r.v2 = buf16(rv, vl, so + 32 * LTOT * 2); r.v3 = buf16(rv, vl, so + 48 * LTOT * 2);
    return r;
}
template <bool CTX, bool ALL>
__device__ __forceinline__ void attn_step(KF& k, VF& v, __amdgpu_buffer_rsrc_t rk, __amdgpu_buffer_rsrc_t rv, int kb_next, int vb_next, unsigned kl, unsigned vl, const LAS unsigned char* qlds,
                                          f32x4 (&o)[4][4], const float m, float (&l)[4], unsigned act, const LAS float* tb0, int lo) {
#pragma unroll
    for (int tp = 0; tp < 4; tp += 2) {
        float s[2][8]; bf16x8 pfv[2];
#pragma unroll
        for (int u = 0; u < 2; ++u) {
            const int t = tp + u;
            if (!ALL && !((act >> t) & 1u)) continue;
            f32x4 s0 = {0.f, 0.f, 0.f, 0.f}, s1 = {0.f, 0.f, 0.f, 0.f};
            const bf16x8 qa = *(const LAS bf16x8*)(qlds + t * 2048), qb = *(const LAS bf16x8*)(qlds + t * 2048 + 1024);
            s0 = __builtin_amdgcn_mfma_f32_16x16x32_bf16(k.k00, qa, s0, 0, 0, 0); s0 = __builtin_amdgcn_mfma_f32_16x16x32_bf16(k.k01, qb, s0, 0, 0, 0);
            s1 = __builtin_amdgcn_mfma_f32_16x16x32_bf16(k.k10, qa, s1, 0, 0, 0); s1 = __builtin_amdgcn_mfma_f32_16x16x32_bf16(k.k11, qb, s1, 0, 0, 0);
#pragma unroll
            for (int e = 0; e < 4; ++e) { s[u][e] = s0[e]; s[u][4 + e] = s1[e]; }
        }
        if (tp == 2) k = load_k(rk, kb_next, kl);
#pragma unroll
        for (int u = 0; u < 2; ++u) {
            const int t = tp + u;
            if (!ALL && !((act >> t) & 1u)) continue;
            if (!CTX) {
                const LAS float* tb = tb0 - t * 64;
                float bv[8];
#pragma unroll
                for (int e = 0; e < 8; ++e) bv[e] = tb[e];
#pragma unroll
                for (int e = 0; e < 8; ++e) asm volatile("" : "+v"(bv[e]));
#pragma unroll
                for (int e = 0; e < 8; ++e) s[u][e] = ((unsigned)(e - lo) < 16u) ? s[u][e] + bv[e] : -1e30f;
            }
            float ps = 0.f;
#pragma unroll
            for (int e = 0; e < 8; ++e) { s[u][e] = __builtin_amdgcn_exp2f(s[u][e] - m); ps += s[u][e]; }
            l[t] += ps;
            union { u32x4 w; bf16x8 v; } pf;
            pf.w.x = cvt_pk_bf16(s[u][0], s[u][1]); pf.w.y = cvt_pk_bf16(s[u][2], s[u][3]); pf.w.z = cvt_pk_bf16(s[u][4], s[u][5]); pf.w.w = cvt_pk_bf16(s[u][6], s[u][7]);
            pfv[u] = pf.v;
        }
#pragma unroll
        for (int u = 0; u < 2; ++u) {
            const int t = tp + u;
            if (!ALL && !((act >> t) & 1u)) continue;
            o[t][0] = __builtin_amdgcn_mfma_f32_16x16x32_bf16(v.v0, pfv[u], o[t][0], 0, 0, 0); o[t][1] = __builtin_amdgcn_mfma_f32_16x16x32_bf16(v.v1, pfv[u], o[t][1], 0, 0, 0);
            o[t][2] = __builtin_amdgcn_mfma_f32_16x16x32_bf16(v.v2, pfv[u], o[t][2], 0, 0, 0); o[t][3] = __builtin_amdgcn_mfma_f32_16x16x32_bf16(v.v3, pfv[u], o[t][3], 0, 0, 0);
        }
    }
    v = load_v(rv, vb_next, vl);
}
__device__ __forceinline__ void attn_phase(const Params& p, LAS unsigned char* lds, int tid, int wid, int lane) {
    LAS float* tbl = (LAS float*)lds;
    LAS unsigned* bmx = (LAS unsigned*)(lds + 30720);
    if (tid == 0) *bmx = 0u;
    __syncthreads();
    for (int i = tid; i < 8 * 15 * 64; i += 512) tbl[i] = 0.f;
    __syncthreads();
    { float bm = 0.f, rv[8];
#pragma unroll
      for (int k = 0; k < 8; ++k) rv[k] = p.rpb[min(tid + 512 * k, 3719)];
#pragma unroll
      for (int k = 0; k < 8; ++k) { const int i = tid + 512 * k;
          if (i < 3720) { const int hd = i / 31, xx = i - hd * 31; const float v = rv[k] * LOG2E; tbl[hd * 64 + 16 + xx] = v; bm = fmaxf(bm, fabsf(v)); } }
      atomicMax((unsigned*)bmx, __float_as_uint(bm)); }
    __syncthreads();
    float kmax;
    { float g = fabsf(p.kg[lane]);
#pragma unroll
      for (int o = 1; o < 64; o <<= 1) g = fmaxf(g, __shfl_xor(g, o));
      kmax = 8.0f * g * 1.001f; }
    const float bmax = __uint_as_float(*bmx);
    const __amdgpu_buffer_rsrc_t rk = __builtin_amdgcn_make_buffer_rsrc((void*)p.Kn, 0, MROWS * 512 * 2, 0x00020000);
    const __amdgpu_buffer_rsrc_t rv = __builtin_amdgcn_make_buffer_rsrc((void*)p.Vt, 0, MROWS * 512 * 2, 0x00020000);
    const int fr = lane & 15, fq = lane >> 4;
    const int nper = ((int)gridDim.x + 7) >> 3;
    for (int pass = 0;; ++pass) {
        const int gi = ((int)blockIdx.x >> 3) * 2 + (wid >> 2) + pass * nper * 2;
        const int pi = gi >> 4;
        const int bh = pi * 8 + ((int)blockIdx.x & 7);
        if (bh >= 64) break;
        const int j = wid & 3, R = gi & 15, h = bh & 7, b = bh >> 3;
        const int cs = (j == 0) ? 0 : (j == 1) ? 8 : (j == 2) ? 24 : 32;
        const int c = 16 * j + fr, c0 = min(max(c - 8, 0), 48);
        const size_t rowbase = (size_t)b * LTOT;
        const int kr_lo = min(max(4 * R - 4, 0), 56), kr_hi = min(max(4 * R - 1, 0), 56) + 8, nwin = kr_hi - kr_lo, nblk = nwin + 8;
        LAS unsigned char* qw = lds + 32768 + wid * 8192 + lane * 16;
        float m = 0.f, l[4];
#pragma unroll
        for (int t = 0; t < 4; ++t) { const bf16_t* qp = p.Q + (rowbase + (4 * R + t) * 64 + c) * 512 + h * 64 + fq * 8;
            const u32x4 qa = *(const u32x4*)qp, qb = *(const u32x4*)(qp + 32);
            *(LAS u32x4*)(qw + t * 2048) = qa; *(LAS u32x4*)(qw + t * 2048 + 1024) = qb;
            float ss = 0.f;
#pragma unroll
            for (int e = 0; e < 4; ++e) { const float a0 = bf_lo(qa[e]), a1 = bf_hi(qa[e]), b0 = bf_lo(qb[e]), b1 = bf_hi(qb[e]); ss += (a0 * a0 + a1 * a1) + (b0 * b0 + b1 * b1); }
            ss = red_sum_fq(ss);
            m = fmaxf(m, sqrtf(ss) * kmax + bmax); l[t] = 0.f; }
        f32x4 o[4][4];
#pragma unroll
        for (int t = 0; t < 4; ++t)
#pragma unroll
            for (int d = 0; d < 4; ++d) o[t][d] = (f32x4){0.f, 0.f, 0.f, 0.f};
        const int kbase = __builtin_amdgcn_readfirstlane((int)((rowbase * 512 + h * 64) * 2));
        const int vbase = __builtin_amdgcn_readfirstlane((int)(((size_t)(b * 8 + h) * 64 * LTOT) * 2));
        const unsigned kl = (unsigned)(((8 * (fr >> 2) + (fr & 3)) * 512 + fq * 8) * 2), vl = (unsigned)((fr * LTOT + fq * 8) * 2);
        const int lo = c0 - (cs + 8 * fq);
        const int dcb = cs + 8 * fq - c + 15 + 16;
        const LAS float* tbh = tbl + h * 960 + dcb;
#define ATT_TOK(i_) __builtin_amdgcn_readfirstlane((min((i_), nblk - 1) < nwin) ? (kr_lo + min((i_), nblk - 1)) * 64 + cs : 4096 + (min((i_), nblk - 1) - nwin) * 32)
#define ATT_STEP(ib_, K_, V_) do { \
            unsigned qad = (unsigned)(size_t)qw; asm volatile("" : "+v"(qad)); const LAS unsigned char* q = (const LAS unsigned char*)(size_t)qad; \
            const int tn_ = ATT_TOK((ib_) + 2); const int kbn_ = kbase + tn_ * 1024; const int vbn_ = vbase + tn_ * 2; \
            if ((ib_) >= nwin) attn_step<true, true>(K_, V_, rk, rv, kbn_, vbn_, kl, vl, q, o, m, l, 15u, tbh, lo); \
            else { const int kr = kr_lo + (ib_); unsigned act = 0; \
                _Pragma("unroll") for (int t = 0; t < 4; ++t) { const int r0 = min(max(4 * R + t - 4, 0), 56); act |= (kr >= r0 && kr < r0 + 8) ? (1u << t) : 0u; } \
                const LAS float* tb0 = tbh + (kr - 4 * R + 7) * 64; \
                if (act == 15u) attn_step<false, true>(K_, V_, rk, rv, kbn_, vbn_, kl, vl, q, o, m, l, 15u, tb0, lo); \
                else attn_step<false, false>(K_, V_, rk, rv, kbn_, vbn_, kl, vl, q, o, m, l, act, tb0, lo); } } while (0)
        KF kA, kB; VF vA, vB;
        { const int t0 = ATT_TOK(0), t1 = ATT_TOK(1);
          kA = load_k(rk, kbase + t0 * 1024, kl); vA = load_v(rv, vbase + t0 * 2, vl); kB = load_k(rk, kbase + t1 * 1024, kl); vB = load_v(rv, vbase + t1 * 2, vl); }
        for (int ib = 0; ib < nblk; ib += 2) {
            ATT_STEP(ib, kA, vA);
            if (ib + 1 < nblk) ATT_STEP(ib + 1, kB, vB);
        }
#undef ATT_STEP
#undef ATT_TOK
        int ln2 = lane; asm volatile("" : "+v"(ln2));
        const int fr2 = ln2 & 15, fq2 = ln2 >> 4, c2 = 16 * j + fr2;
        u32x2 gg[4][4];
#pragma unroll
        for (int t = 0; t < 4; ++t) {
            const bf16_t* bgp = p.BG + (rowbase + (4 * R + t) * 64 + c2) * 512 + h * 64 + 4 * fq2;
#pragma unroll
            for (int d = 0; d < 4; ++d) gg[t][d] = *(const u32x2*)(bgp + 16 * d);
        }
#pragma unroll
        for (int t = 0; t < 4; ++t) {
            const float inv = 1.0f / red_sum_fq(l[t]);
            bf16_t* op = p.MIX + ((size_t)b * 4096 + (4 * R + t) * 64 + c2) * 1024 + 512 + h * 64 + 4 * fq2;
#pragma unroll
            for (int d = 0; d < 4; ++d) {
                u32x2 w; w.x = cvt_pk_bf16(o[t][d][0] * inv * bf_lo(gg[t][d].x), o[t][d][1] * inv * bf_hi(gg[t][d].x)); w.y = cvt_pk_bf16(o[t][d][2] * inv * bf_lo(gg[t][d].y), o[t][d][3] * inv * bf_hi(gg[t][d].y));
                *(u32x2*)(op + 16 * d) = w;
            }
        }
    }
}

__device__ __forceinline__ void run_phase(const Params& p, int ph, LAS unsigned char* lds) {
    int tid_ = threadIdx.x; asm volatile("" : "+v"(tid_));
    const int tid = tid_, wid = __builtin_amdgcn_readfirstlane(tid >> 6), lane = tid & 63;
    if (ph == 0) phase0(p, lds, tid);
    else if (ph == 1) phase1(p, lds, tid, wid, lane);
    else if (ph == 2) {
        pg8::Gemm g{p.H, p.WinT, MROWS, 3584, 1024};
        Sched1 S{(int)gridDim.x, (int)blockIdx.x};
        Epi1 E{p.U, p.Vg, p.G, p.Q, p.Kn, p.BG, p.Vt, p.qg, p.kg};
        pg8::gemm_phase<Epi1, Sched1>(lds, g, S, E);
    } else if (ph == 3) {
        sgu_phase(p, lds, tid, wid, lane);
        attn_phase(p, lds, tid, wid, lane);
    } else {
        pg8::Gemm g{p.MIX, p.WoutT, 32768, 1024, 1024};
        pg8::StaticOrder S; S.init(32768, 1024, (int)gridDim.x, (int)blockIdx.x);
        EpiOut E{p.x, p.gatef, p.out};
        pg8::gemm_phase<EpiOut, pg8::StaticOrder>(lds, g, S, E);
    }
}

#if ONE_LAUNCH
__global__ __launch_bounds__(512, 2) void k_mega(Params p) {
    extern __shared__ __attribute__((aligned(16))) unsigned char shm[];
    LAS unsigned char* lds = (LAS unsigned char*)shm;
    volatile LAS unsigned* st = (volatile LAS unsigned*)(lds + 131072);
    if (threadIdx.x == 0) { st[0] = 0u; st[1] = 0u; st[2] = 0u; st[3] = 0u; }
    __syncthreads();
    const XcdBarrier xb = xcd_barrier_post(p.bar, st);
    if (p.out == nullptr) cg::this_grid().sync();
    run_phase(p, 0, lds); xcd_barrier(xb);
    run_phase(p, 1, lds); xcd_barrier(xb);
    run_phase(p, 2, lds); xcd_barrier(xb);
    run_phase(p, 3, lds); xcd_barrier(xb);
#if PROBE_PH == 31
    attn_phase(p, lds, threadIdx.x, __builtin_amdgcn_readfirstlane(threadIdx.x >> 6), threadIdx.x & 63); xcd_barrier(xb);
#elif PROBE_PH == 30
    sgu_phase(p, lds, threadIdx.x, __builtin_amdgcn_readfirstlane(threadIdx.x >> 6), threadIdx.x & 63); xcd_barrier(xb);
#elif PROBE_PH >= 0 && PROBE_PH <= 2
    run_phase(p, PROBE_PH, lds); xcd_barrier(xb);
#elif PROBE_PH == 50
    xcd_barrier(xb); xcd_barrier(xb); xcd_barrier(xb); xcd_barrier(xb);
#endif
    run_phase(p, 4, lds);
#if PROBE_PH == 4
    xcd_barrier(xb); run_phase(p, 4, lds);
#endif
}
#else
template <int PH> __global__ __launch_bounds__(512, 2) void k_phase(Params p) {
    extern __shared__ __attribute__((aligned(16))) unsigned char shm[];
    run_phase(p, PH, (LAS unsigned char*)shm);
}
#endif

extern "C" void kernel_launch(void* const* d_in, const int* in_sizes, int n_in, void* d_out, int out_size, void* d_ws, size_t ws_size, hipStream_t stream) {
    Params p{};
    p.x = (const float*)d_in[0]; p.c = (const float*)d_in[1]; p.ctx = (const float*)d_in[2]; p.c_ctx = (const float*)d_in[3];
    p.w_ada = (const float*)d_in[4]; p.b_ada = (const float*)d_in[5]; p.norm_g = (const float*)d_in[6]; p.w_in = (const float*)d_in[7];
    p.sgu_g = (const float*)d_in[8]; p.w_sp = (const float*)d_in[9]; p.b_sp = (const float*)d_in[10]; p.qg = (const float*)d_in[11];
    p.kg = (const float*)d_in[12]; p.rpb = (const float*)d_in[13]; p.w_out = (const float*)d_in[14];
    p.out = (float*)d_out;
    unsigned char* w = (unsigned char*)d_ws; size_t off = 0;
    auto take = [&](size_t bytes) { unsigned char* r = w + off; off += (bytes + 255) & ~(size_t)255; return r; };
    p.modp = (float*)take((size_t)32 * 9 * 3072 * 4);
    p.gatef = (float*)take((size_t)8 * 1024 * 4);
    p.H = (bf16_t*)take((size_t)MROWS * 1024 * 2);
    p.WinT = (bf16_t*)take((size_t)3584 * 1024 * 2);
    p.WoutT = (bf16_t*)take((size_t)1024 * 1024 * 2);
    p.Wsp = (bf16_t*)take((size_t)4 * 128 * 128 * 2);
    p.U = (bf16_t*)take((size_t)MROWS * 512 * 2); p.Vg = (bf16_t*)take((size_t)MROWS * 512 * 2); p.G = (bf16_t*)take((size_t)MROWS * 512 * 2);
    p.Q = (bf16_t*)take((size_t)MROWS * 512 * 2); p.Kn = (bf16_t*)take((size_t)MROWS * 512 * 2); p.BG = (bf16_t*)take((size_t)MROWS * 512 * 2);
    p.Vt = (bf16_t*)take((size_t)8 * 8 * 64 * LTOT * 2);
    p.MIX = (bf16_t*)take((size_t)32768 * 1024 * 2);
    p.bar = (unsigned*)take((size_t)(XCD_BAR_WORDS + 512) * 4);
    if (off > ws_size) { fprintf(stderr, "kernel_launch: workspace too small (%zu needed, %zu given)\n", off, ws_size); return; }
#if ONE_LAUNCH
    static int grid = 0;
    if (grid == 0) {
        int dev = 0, cus = 0, per_cu = 0;
        hipGetDevice(&dev); hipDeviceGetAttribute(&cus, hipDeviceAttributeMultiprocessorCount, dev);
        hipFuncSetAttribute((const void*)k_mega, hipFuncAttributeMaxDynamicSharedMemorySize, LDS_BYTES);
        hipOccupancyMaxActiveBlocksPerMultiprocessor(&per_cu, (const void*)k_mega, 512, LDS_BYTES);
        if (per_cu < 1) { fprintf(stderr, "kernel_launch: occupancy query says %d blocks per CU\n", per_cu); per_cu = 1; }
        if (per_cu > 1) per_cu = 1;
        grid = cus * per_cu;
    }
    (void)hipMemsetAsync(p.bar, 0, (size_t)(XCD_BAR_WORDS + 512) * 4, stream);
    void* args[] = {&p};
    hipError_t e = hipLaunchCooperativeKernel((const void*)k_mega, dim3(grid), dim3(512), args, LDS_BYTES, stream);
    if (e != hipSuccess) fprintf(stderr, "cooperative launch failed: %s (grid %d)\n", hipGetErrorString(e), grid);
#else
    static int inited = 0;
    if (!inited) {
        hipFuncSetAttribute((const void*)k_phase<0>, hipFuncAttributeMaxDynamicSharedMemorySize, LDS_BYTES);
        hipFuncSetAttribute((const void*)k_phase<1>, hipFuncAttributeMaxDynamicSharedMemorySize, LDS_BYTES);
        hipFuncSetAttribute((const void*)k_phase<2>, hipFuncAttributeMaxDynamicSharedMemorySize, LDS_BYTES);
        hipFuncSetAttribute((const void*)k_phase<3>, hipFuncAttributeMaxDynamicSharedMemorySize, LDS_BYTES);
        hipFuncSetAttribute((const void*)k_phase<4>, hipFuncAttributeMaxDynamicSharedMemorySize, LDS_BYTES);
        inited = 1;
    }
    const int grid = 256;
    hipLaunchKernelGGL(k_phase<0>, dim3(grid), dim3(512), LDS_BYTES, stream, p);
    hipLaunchKernelGGL(k_phase<1>, dim3(grid), dim3(512), LDS_BYTES, stream, p);
    hipLaunchKernelGGL(k_phase<2>, dim3(grid), dim3(512), LDS_BYTES, stream, p);
    hipLaunchKernelGGL(k_phase<3>, dim3(grid), dim3(512), LDS_BYTES, stream, p);
    hipLaunchKernelGGL(k_phase<4>, dim3(grid), dim3(512), LDS_BYTES, stream, p);
#endif
}
```
